# Optimizing an MI355X kernel written in HIP

```python
import jax, jax.numpy as jnp
from jax import lax
import numpy as np

D_MODEL = 2048
BATCH = 4
SEQ = 4096
DEPTH = 1
DEC_BATCH = 128
DEC_SEQ = 1
PAST_LEN = 16384
PAGE_SIZE = 128

N_META = 16
MIX_DIM = D_MODEL
CONV_DIM = MIX_DIM // 2
CONV_W = 3
HEAD_DIM = 64
ATTN_DIM = MIX_DIM - CONV_DIM
N_HEADS = ATTN_DIM // HEAD_DIM
N_KV_HEADS = 4
GROUP = N_HEADS // N_KV_HEADS
KV_DIM = N_KV_HEADS * HEAD_DIM
WINDOW = 128
BLOCK = WINDOW
ROPE_THETA = 10000.0
D_FF = ((8 * D_MODEL + 767) // 768) * 256
RMS_EPS = 1e-6
NEG_INF = -1e30
IN_COLS = 3 * CONV_DIM + ATTN_DIM + 2 * KV_DIM
SPLIT_POINTS = (CONV_DIM, 2 * CONV_DIM, 3 * CONV_DIM, 3 * CONV_DIM + ATTN_DIM, 3 * CONV_DIM + ATTN_DIM + KV_DIM)

kernel_name = "hymba_conv_swa_sink_decoder_step"


def rms_norm(x, g):
    x32 = x.astype(jnp.float32)
    y = x32 * lax.rsqrt(jnp.mean(x32 * x32, axis=-1, keepdims=True) + RMS_EPS)
    return (y * g.astype(jnp.float32)).astype(x.dtype)


def rope(x, pos):
    half = HEAD_DIM // 2
    inv = ROPE_THETA ** (-jnp.arange(half, dtype=jnp.float32) / half)
    ang = pos.astype(jnp.float32)[:, None] * inv[None, :]
    cos = jnp.cos(ang)[:, None, :]
    sin = jnp.sin(ang)[:, None, :]
    x32 = x.astype(jnp.float32)
    x1, x2 = x32[..., :half], x32[..., half:]
    return jnp.concatenate([x1 * cos - x2 * sin, x2 * cos + x1 * sin], axis=-1).astype(x.dtype)


def project(hn, w_in):
    n, t, _ = hn.shape
    z = hn @ w_in
    b_gate, c_gate, xc, q, k, v = jnp.split(z, SPLIT_POINTS, axis=-1)
    q = q.reshape(n, t, N_HEADS, HEAD_DIM)
    k = k.reshape(n, t, N_KV_HEADS, HEAD_DIM)
    v = v.reshape(n, t, N_KV_HEADS, HEAD_DIM)
    return b_gate, c_gate, xc, q, k, v


def short_conv(u_ext, w):
    t = u_ext.shape[1] - (CONV_W - 1)
    return sum(w[j] * u_ext[:, j:j + t] for j in range(CONV_W))


def sink_softmax(s, mask, sinks):
    sink = sinks.astype(jnp.float32).reshape(N_KV_HEADS, GROUP, 1, 1)
    s = jnp.where(mask, s, NEG_INF)
    m = jnp.maximum(jnp.max(s, axis=-1, keepdims=True), sink)
    p = jnp.exp(s - m)
    denom = jnp.sum(p, axis=-1, keepdims=True) + jnp.exp(sink - m)
    return p / denom


def attn_prompt(q, k, v, sinks):
    b, l = q.shape[0], q.shape[1]
    pad = BLOCK - N_META
    nb = (l + pad) // BLOCK
    qb = jnp.pad(q, ((0, 0), (pad, 0), (0, 0), (0, 0))).reshape(b, nb, BLOCK, N_KV_HEADS, GROUP, HEAD_DIM)
    kp = jnp.pad(k, ((0, 0), (pad + BLOCK, 0), (0, 0), (0, 0))).reshape(b, nb + 1, BLOCK, N_KV_HEADS, HEAD_DIM)
    vp = jnp.pad(v, ((0, 0), (pad + BLOCK, 0), (0, 0), (0, 0))).reshape(b, nb + 1, BLOCK, N_KV_HEADS, HEAD_DIM)
    kb = jnp.concatenate([kp[:, :-1], kp[:, 1:]], axis=2)
    vb = jnp.concatenate([vp[:, :-1], vp[:, 1:]], axis=2)
    s = jnp.einsum('bnqkgd,bnskd->bnkgqs', qb, kb, preferred_element_type=jnp.float32) * (HEAD_DIM ** -0.5)
    blk = jnp.arange(nb)[:, None, None]
    qi = jnp.arange(BLOCK)[None, :, None]
    kj = jnp.arange(2 * BLOCK)[None, None, :]
    pos_q = blk * BLOCK + qi - pad
    pos_k = blk * BLOCK + kj - BLOCK - pad
    diff = pos_q - pos_k
    mask = ((pos_k >= 0) & (diff >= 0) & (diff <= WINDOW))[:, None, None]
    p = sink_softmax(s, mask, sinks)
    o = jnp.einsum('bnkgqs,bnskd->bnqkgd', p.astype(v.dtype), vb)
    return o.reshape(b, nb * BLOCK, ATTN_DIM)[:, pad:]


def attn_sample(q, k_all, v_all, sinks):
    n, t = q.shape[0], q.shape[1]
    qg = q.reshape(n, t, N_KV_HEADS, GROUP, HEAD_DIM)
    s = jnp.einsum('btkgd,bskd->bkgts', qg, k_all, preferred_element_type=jnp.float32) * (HEAD_DIM ** -0.5)
    pos_q = PAST_LEN + jnp.arange(t)
    pos_k = PAST_LEN - WINDOW + jnp.arange(k_all.shape[1])
    diff = pos_q[:, None] - pos_k[None, :]
    mask = (diff >= 0) & (diff <= WINDOW)
    p = sink_softmax(s, mask, sinks)
    o = jnp.einsum('bkgts,bskd->btkgd', p.astype(v_all.dtype), v_all)
    return o.reshape(n, t, ATTN_DIM)


def merge_groups(b_gate, conv_y, attn_o, conv_g, attn_g, w_out):
    yc = rms_norm(b_gate * conv_y, conv_g)
    ya = rms_norm(attn_o, attn_g)
    return jnp.concatenate([yc, ya], axis=-1) @ w_out


def swiglu(hn, w_gate, w_up, w_down):
    return (jax.nn.silu(hn @ w_gate) * (hn @ w_up)) @ w_down


def setup_inputs(seed: int = 0) -> dict:
    key = jax.random.key(seed)
    ks = jax.random.split(key, 20)
    f32 = jnp.float32
    nrm = lambda k, shape, sc: jax.random.normal(k, shape, f32) * sc
    return {
        "x_prompt": nrm(ks[0], (BATCH, SEQ, D_MODEL), 1.0),
        "x_sample": nrm(ks[1], (DEC_BATCH, DEC_SEQ, D_MODEL), 1.0),
        "cache_k": nrm(ks[2], (DEPTH, DEC_BATCH, WINDOW, N_KV_HEADS, HEAD_DIM), 1.0),
        "cache_v": nrm(ks[3], (DEPTH, DEC_BATCH, WINDOW, N_KV_HEADS, HEAD_DIM), 1.0),
        "state_conv": nrm(ks[4], (DEPTH, DEC_BATCH, CONV_W - 1, CONV_DIM), 1.0),
        "meta_tokens": nrm(ks[5], (N_META, D_MODEL), 1.0),
        "norm1_g": 1.0 + nrm(ks[6], (DEPTH, D_MODEL), 0.02),
        "w_in": nrm(ks[7], (DEPTH, D_MODEL, IN_COLS), D_MODEL ** -0.5),
        "conv_w": nrm(ks[8], (DEPTH, CONV_W, CONV_DIM), CONV_W ** -0.5),
        "conv_norm_g": 1.0 + nrm(ks[9], (DEPTH, CONV_DIM), 0.02),
        "attn_norm_g": 1.0 + nrm(ks[10], (DEPTH, ATTN_DIM), 0.02),
        "attn_sinks": nrm(ks[11], (DEPTH, N_HEADS), 1.0),
        "w_out": nrm(ks[12], (DEPTH, MIX_DIM, D_MODEL), MIX_DIM ** -0.5),
        "norm2_g": 1.0 + nrm(ks[13], (DEPTH, D_MODEL), 0.02),
        "w_gate": nrm(ks[14], (DEPTH, D_MODEL, D_FF), D_MODEL ** -0.5),
        "w_up": nrm(ks[15], (DEPTH, D_MODEL, D_FF), D_MODEL ** -0.5),
        "w_down": nrm(ks[16], (DEPTH, D_FF, D_MODEL), D_FF ** -0.5),
        "final_norm_g": 1.0 + nrm(ks[17], (D_MODEL,), 0.02),
    }


def reference(x_prompt, x_sample, cache_k, cache_v, state_conv, meta_tokens, norm1_g, w_in, conv_w,
              conv_norm_g, attn_norm_g, attn_sinks, w_out, norm2_g, w_gate, w_up, w_down, final_norm_g):
    nbp = x_prompt.shape[0]
    meta = jnp.broadcast_to(meta_tokens[None].astype(x_prompt.dtype), (nbp, N_META, D_MODEL))
    hp = jnp.concatenate([meta, x_prompt], axis=1)
    hs = x_sample
    pos_p = jnp.arange(hp.shape[1])
    pos_s = PAST_LEN + jnp.arange(hs.shape[1])
    nkp, nvp, ncp, nks, nvs, ncs = [], [], [], [], [], []
    for l in range(DEPTH):
        hn = rms_norm(hp, norm1_g[l])
        bg, cg, xc, q, k, v = project(hn, w_in[l])
        u = cg * xc
        cy = short_conv(jnp.pad(u, ((0, 0), (CONV_W - 1, 0), (0, 0))), conv_w[l])
        q = rope(q, pos_p)
        k = rope(k, pos_p)
        ao = attn_prompt(q, k, v, attn_sinks[l])
        hp = hp + merge_groups(bg, cy, ao, conv_norm_g[l], attn_norm_g[l], w_out[l])
        hp = hp + swiglu(rms_norm(hp, norm2_g[l]), w_gate[l], w_up[l], w_down[l])
        nkp.append(k[:, -WINDOW:])
        nvp.append(v[:, -WINDOW:])
        ncp.append(u[:, -(CONV_W - 1):])
        hn = rms_norm(hs, norm1_g[l])
        bg, cg, xc, q, k, v = project(hn, w_in[l])
        u_ext = jnp.concatenate([state_conv[l].astype(hs.dtype), cg * xc], axis=1)
        cy = short_conv(u_ext, conv_w[l])
        q = rope(q, pos_s)
        k = rope(k, pos_s)
        k_all = jnp.concatenate([cache_k[l].astype(k.dtype), k], axis=1)
        v_all = jnp.concatenate([cache_v[l].astype(v.dtype), v], axis=1)
        ao = attn_sample(q, k_all, v_all, attn_sinks[l])
        hs = hs + merge_groups(bg, cy, ao, conv_norm_g[l], attn_norm_g[l], w_out[l])
        hs = hs + swiglu(rms_norm(hs, norm2_g[l]), w_gate[l], w_up[l], w_down[l])
        nks.append(k_all[:, -WINDOW:])
        nvs.append(v_all[:, -WINDOW:])
        ncs.append(u_ext[:, -(CONV_W - 1):])
    y_prompt = rms_norm(hp[:, N_META:], final_norm_g)
    y_sample = rms_norm(hs, final_norm_g)
    return (y_prompt, y_sample, jnp.stack(nkp), jnp.stack(nvp), jnp.stack(ncp),
            jnp.stack(nks), jnp.stack(nvs), jnp.stack(ncs))
```

```cpp
#include <hip/hip_runtime.h>
#include <hip/hip_cooperative_groups.h>
#include <cstdio>
namespace cg = cooperative_groups;

#define PG8_LAS __attribute__((address_space(3)))
typedef unsigned short bf16_t;
typedef short bf16x8 __attribute__((ext_vector_type(8)));
typedef float f32x4 __attribute__((ext_vector_type(4)));
typedef float f32x16 __attribute__((ext_vector_type(16)));
typedef unsigned u32x4 __attribute__((ext_vector_type(4)));
typedef unsigned u32x2 __attribute__((ext_vector_type(2)));

constexpr int D = 2048, SEQ = 4096, NB = 4, NS = 128, NMETA = 16;
constexpr int MP = NB * SEQ;
constexpr int ROW_S = MP;
constexpr int ROW_M = MP + NS;
constexpr int ROW_E = ROW_M + NMETA;
constexpr int MROWS = 16640;
constexpr int NREAL = ROW_M;
constexpr int CONVD = 1024, ATTD = 1024, KVD = 256, HD = 64;
constexpr int INC = 4608, FF = 5632, GU = 2 * FF;
constexpr int NTHREADS = 512;
constexpr int PAST = 16384;
constexpr float EPS = 1e-6f;
constexpr int ROPE_ROWS = SEQ + NMETA + 1;

constexpr size_t OFF_Y = 0;
constexpr size_t OFF_KP = (size_t)(MP + NS) * D;
constexpr size_t OFF_VP = OFF_KP + (size_t)NB * 128 * KVD;
constexpr size_t OFF_CP = OFF_VP + (size_t)NB * 128 * KVD;
constexpr size_t OFF_KS = OFF_CP + (size_t)NB * 2 * CONVD;
constexpr size_t OFF_VS = OFF_KS + (size_t)NS * 128 * KVD;
constexpr size_t OFF_CS = OFF_VS + (size_t)NS * 128 * KVD;
constexpr size_t OUT_TOTAL = OFF_CS + (size_t)NS * 2 * CONVD;

constexpr size_t WS_WIN = 0;
constexpr size_t WS_WOUT = WS_WIN + (size_t)INC * D * 2;
constexpr size_t WS_WGU = WS_WOUT + (size_t)D * D * 2;
constexpr size_t WS_WDN = WS_WGU + (size_t)GU * D * 2;
constexpr size_t WS_HN = WS_WDN + (size_t)D * FF * 2;
constexpr size_t WS_C = WS_HN + (size_t)MROWS * D * 2;
constexpr size_t WS_BG = WS_C;
constexpr size_t WS_U = WS_BG + (size_t)MROWS * CONVD * 2;
constexpr size_t WS_Q = WS_U + (size_t)MROWS * CONVD * 2;
constexpr size_t WS_K = WS_Q + (size_t)MROWS * ATTD * 2;
constexpr size_t WS_V = WS_K + (size_t)MROWS * KVD * 2;
constexpr size_t WS_M = WS_V + (size_t)MROWS * KVD * 2;
constexpr size_t WS_HF = WS_C;
constexpr size_t WS_CEND = WS_C + (size_t)MROWS * FF * 2;
static_assert(WS_M + (size_t)MROWS * D * 2 <= WS_CEND, "region C");
constexpr size_t WS_ROPE = WS_CEND;
constexpr size_t WS_SS1 = WS_ROPE + (size_t)ROPE_ROWS * 64 * 4;
constexpr size_t WS_SS2 = WS_SS1 + (size_t)MROWS * 32 * 4;
constexpr size_t WS_END = WS_SS2 + (size_t)MROWS * 32 * 4;

__device__ __forceinline__ unsigned cvt_pk_bf16(float lo, float hi) { unsigned r; asm volatile("v_cvt_pk_bf16_f32 %0, %1, %2" : "=v"(r) : "v"(lo), "v"(hi)); return r; }
__device__ __forceinline__ float bf_lo(unsigned u) { return __uint_as_float(u << 16); }
__device__ __forceinline__ float bf_hi(unsigned u) { return __uint_as_float(u & 0xffff0000u); }
__device__ __forceinline__ float bf2f(bf16_t x) { return __uint_as_float((unsigned)x << 16); }
__device__ __forceinline__ float wave_sum(float v) {
#pragma unroll
    for (int o = 32; o >= 1; o >>= 1) v += __shfl_xor(v, o);
    return v;
}
__device__ __forceinline__ float wave_max(float v) {
#pragma unroll
    for (int o = 32; o >= 1; o >>= 1) v = fmaxf(v, __shfl_xor(v, o));
    return v;
}
__device__ __forceinline__ int tpos_of_row(int row) { return row < MP ? NMETA + (row & (SEQ - 1)) : (row < ROW_M ? (SEQ + NMETA) : (row < ROW_E ? row - ROW_M : 0)); }

namespace pg8 {
constexpr int BM = 256, BK = 64, HALF = 128, HTB = HALF * BK * 2  , STAGE_BYTES = 8 * HTB, NXCD = 8, WGM = 8;
__host__ __device__ __forceinline__ int lds_byte(int r, int c) { const int st = (r >> 4) * 2 + (c >> 5), rr = r & 15, cc = c & 31, ob = rr * 64 + cc * 2; return st * 1024 + (ob ^ (((ob >> 9) & 1) << 5)); }
__host__ __device__ __forceinline__ void stage_rc(int b, int& R, int& C) { const int st = b / 1024, sb = b % 1024, swz = sb ^ (((sb >> 9) & 1) << 5); R = (st >> 1) * 16 + swz / 64; C = (st & 1) * 32 + (swz % 64) / 2; }
__host__ __device__ __forceinline__ int perm32(int rho) { const int n = rho >> 4, i = rho & 15; return 8 * (i >> 2) + 4 * n + (i & 3); }

struct Unit { int pm, pn; };
struct Gemm { const bf16_t* A; const bf16_t* Bt; int M, N, K; };

struct StaticOrder {
    int nM, nN, nwg, G, c;
    __host__ __device__ void init(int M, int N, int G_, int c_) { nM = M / BM; nN = N / BM; nwg = nM * nN; G = G_; c = c_; }
    __host__ __device__ bool next(int i, Unit& u) const {
        const long L = (long)i * G + c; if (L >= nwg) return false;
        int wgid = (int)L; { const int q = nwg / NXCD, r = nwg % NXCD, xcd = wgid % NXCD, off = wgid / NXCD; wgid = (xcd < r ? xcd * (q + 1) : r * (q + 1) + (xcd - r) * q) + off; }
        const int nig = WGM * nN, gid = wgid / nig, fm = gid * WGM, gsz = (nM - fm) < WGM ? (nM - fm) : WGM;
        u.pm = fm + ((wgid % nig) % gsz); u.pn = (wgid % nig) / gsz; return true;
    }
    __device__ __forceinline__ void a_ready(const Unit&) const {}
    __device__ __forceinline__ void done(const Unit&) const {}
};

template <class Epi, class Sched>
__device__ __forceinline__ void gemm_phase(PG8_LAS unsigned char* lds, const Gemm g, const Sched& S, const Epi& E) {
    const int tid = threadIdx.x, wid = __builtin_amdgcn_readfirstlane(tid >> 6), lane = tid & 63, wr = wid >> 2, wc = wid & 3, fr = lane & 15, fq = lane >> 4;
    const int K = g.K, nt = K / BK;
    unsigned voffA[2], voffB[2];
#pragma unroll
    for (int i = 0; i < 2; ++i) { int R, C; stage_rc(tid * 16 + i * 8192, R, C); const int Rb = Epi::PERM ? ((R & ~31) + perm32(R & 31)) : R;
        voffA[i] = (unsigned)(R * K + C) * 2u; voffB[i] = (unsigned)(Rb * K + C) * 2u; }
    const size_t kstep = (size_t)(BK * 2);
    const size_t hstep = (size_t)HALF * K * 2;
    const size_t tstep = 2 * hstep;
    const unsigned ldsw = (unsigned)wid * 1024u;
    const int aoff = lds_byte(wr * 64 + fr, fq * 8), boff = lds_byte(wc * 32 + fr, fq * 8);
#define PG8_SA(b, h) (((b) * 2 + (h)) * HTB)
#define PG8_SB(b, h) ((4 + (b) * 2 + (h)) * HTB)
#define PG8_STAGE(bufoff, gbase, voff) do { _Pragma("unroll") for (int _i = 0; _i < 2; ++_i) \
        __builtin_amdgcn_global_load_lds((const unsigned*)((const char*)(gbase) + (voff)[_i]), (PG8_LAS unsigned*)(lds + (bufoff) + ldsw + _i * 8192), 16, 0, 0); } while (0)
#define PG8_LDA(dst, b, h) do { _Pragma("unroll") for (int m = 0; m < 4; ++m) _Pragma("unroll") for (int k = 0; k < 2; ++k) dst[m][k] = *(const PG8_LAS bf16x8*)(lds + PG8_SA(b, h) + aoff + m * 2048 + k * 1024); } while (0)
#define PG8_LDB(dst, b, h) do { _Pragma("unroll") for (int n = 0; n < 2; ++n) _Pragma("unroll") for (int k = 0; k < 2; ++k) dst[n][k] = *(const PG8_LAS bf16x8*)(lds + PG8_SB(b, h) + boff + n * 2048 + k * 1024); } while (0)
#define PG8_MMA(ai, bj, At, Bt) do { __builtin_amdgcn_s_setprio(1); _Pragma("unroll") for (int m = 0; m < 4; ++m) _Pragma("unroll") for (int n = 0; n < 2; ++n) _Pragma("unroll") for (int k = 0; k < 2; ++k) \
        acc[ai][bj][m][n] = __builtin_amdgcn_mfma_f32_16x16x32_bf16(Bt[n][k], At[m][k], acc[ai][bj][m][n], 0, 0, 0); __builtin_amdgcn_s_setprio(0); } while (0)
#define PG8_WAIT_V(n) asm volatile("s_waitcnt vmcnt(" #n ")" ::: "memory")
#define PG8_WAIT_L(n) asm volatile("s_waitcnt lgkmcnt(" #n ")" ::: "memory")
#define PG8_BAR __builtin_amdgcn_s_barrier()
#define PG8_SCHED __builtin_amdgcn_sched_barrier(0)
    Unit cur, nxt; int ui = 0;
    if (!S.next(0, cur)) return;
    f32x4 acc[2][2][4][2];
#pragma unroll
    for (int a = 0; a < 2; ++a)
#pragma unroll
        for (int b = 0; b < 2; ++b)
#pragma unroll
            for (int m = 0; m < 4; ++m)
#pragma unroll
                for (int n = 0; n < 2; ++n) acc[a][b][m][n] = (f32x4){0.f, 0.f, 0.f, 0.f};
    bf16x8 At[4][2], B0[2][2], B1[2][2];
    const char* cA = (const char*)g.A + (size_t)cur.pm * tstep; const char* cB = (const char*)g.Bt + (size_t)cur.pn * tstep;
    S.a_ready(cur);
    PG8_STAGE(PG8_SB(0, 0), cB, voffB); PG8_STAGE(PG8_SA(0, 0), cA, voffA); PG8_STAGE(PG8_SB(0, 1), cB + hstep, voffB); PG8_STAGE(PG8_SA(0, 1), cA + hstep, voffA);
    if (wr == 1) PG8_BAR;
    PG8_WAIT_V(4); PG8_BAR;
    PG8_STAGE(PG8_SB(1, 0), cB + kstep, voffB); PG8_STAGE(PG8_SA(1, 0), cA + kstep, voffA); PG8_STAGE(PG8_SB(1, 1), cB + hstep + kstep, voffB);
    PG8_WAIT_V(6); PG8_BAR;
    for (;;) {
        const bool has_next = S.next(ui + 1, nxt);
        const char* nA = has_next ? (const char*)g.A + (size_t)nxt.pm * tstep : cA; const char* nB = has_next ? (const char*)g.Bt + (size_t)nxt.pn * tstep : cB;
        for (int t = 0; t < nt; t += 2) {
            const bool last = (t == nt - 2);
            const char* a1 = cA + (size_t)(t + 1) * kstep;
            const char* a2 = last ? nA : cA + (size_t)(t + 2) * kstep; const char* b2 = last ? nB : cB + (size_t)(t + 2) * kstep;
            const char* a3 = a2 + kstep; const char* b3 = b2 + kstep;
            if (last && has_next) S.a_ready(nxt);
            PG8_LDB(B0, 0, 0); PG8_SCHED; PG8_LDA(At, 0, 0); PG8_STAGE(PG8_SA(1, 1), a1 + hstep, voffA);
            PG8_WAIT_L(8); PG8_BAR; PG8_WAIT_L(0); PG8_MMA(0, 0, At, B0); PG8_BAR; PG8_SCHED;
            PG8_LDB(B1, 0, 1); PG8_STAGE(PG8_SB(0, 0), b2, voffB);
            PG8_BAR; PG8_WAIT_L(0); PG8_MMA(0, 1, At, B1); PG8_BAR;
            PG8_LDA(At, 0, 1); PG8_STAGE(PG8_SA(0, 0), a2, voffA);
            PG8_BAR; PG8_WAIT_L(0); PG8_MMA(1, 0, At, B0); PG8_BAR; PG8_SCHED;
            PG8_STAGE(PG8_SB(0, 1), b2 + hstep, voffB);
            PG8_WAIT_V(6); PG8_BAR; PG8_MMA(1, 1, At, B1); PG8_BAR;
            PG8_LDB(B0, 1, 0); PG8_SCHED; PG8_LDA(At, 1, 0); PG8_STAGE(PG8_SA(0, 1), a2 + hstep, voffA);
            PG8_WAIT_L(8); PG8_BAR; PG8_WAIT_L(0); PG8_MMA(0, 0, At, B0); PG8_BAR; PG8_SCHED;
            PG8_LDB(B1, 1, 1); PG8_STAGE(PG8_SB(1, 0), b3, voffB);
            PG8_BAR; PG8_WAIT_L(0); PG8_MMA(0, 1, At, B1); PG8_BAR;
            PG8_LDA(At, 1, 1); PG8_STAGE(PG8_SA(1, 0), a3, voffA);
            PG8_BAR; PG8_WAIT_L(0); PG8_MMA(1, 0, At, B0); PG8_BAR; PG8_SCHED;
            PG8_STAGE(PG8_SB(1, 1), b3 + hstep, voffB);
            PG8_WAIT_V(6); PG8_BAR; PG8_MMA(1, 1, At, B1); PG8_BAR;
        }
        if constexpr (!Epi::AFTER_DRAIN) { E(acc, cur, wr, wc, fr, fq); S.done(cur); }
        if (!has_next) break;
#pragma unroll
        for (int a = 0; a < 2; ++a)
#pragma unroll
            for (int b = 0; b < 2; ++b)
#pragma unroll
                for (int m = 0; m < 4; ++m)
#pragma unroll
                    for (int n = 0; n < 2; ++n) acc[a][b][m][n] = (f32x4){0.f, 0.f, 0.f, 0.f};
        cur = nxt; cA = nA; cB = nB; ++ui;
    }
    PG8_WAIT_V(0);
    if (wr == 0) PG8_BAR;
    PG8_BAR;
    if constexpr (Epi::AFTER_DRAIN) { E.fused(acc, cur, wr, wc, fr, fq, lds, wid, lane); S.done(cur); }
#undef PG8_SA
#undef PG8_SB
#undef PG8_STAGE
#undef PG8_LDA
#undef PG8_LDB
#undef PG8_MMA
#undef PG8_WAIT_V
#undef PG8_WAIT_L
#undef PG8_BAR
#undef PG8_SCHED
}
}
using pg8::Unit; using pg8::BM; using pg8::HALF;

__device__ __forceinline__ u32x4 pack8(const f32x4 a, const f32x4 b) { u32x4 w; w.x = cvt_pk_bf16(a[0], a[1]); w.y = cvt_pk_bf16(a[2], a[3]); w.z = cvt_pk_bf16(b[0], b[1]); w.w = cvt_pk_bf16(b[2], b[3]); return w; }
__device__ __forceinline__ u32x2 pack4(const f32x4 a) { u32x2 w; w.x = cvt_pk_bf16(a[0], a[1]); w.y = cvt_pk_bf16(a[2], a[3]); return w; }

struct EpiIn {
    static constexpr bool PERM = true, AFTER_DRAIN = false;
    bf16_t *bg, *u, *q, *k, *v; const float* rope;
    __device__ __forceinline__ void operator()(const f32x4 (&acc)[2][2][4][2], const Unit& un, int wr, int wc, int fr, int fq) const {
        const int row0 = un.pm * BM + wr * 64 + fr, pn = un.pn;
        if (pn < 4 || pn == 17) {
            bf16_t* base = pn < 4 ? bg : v; const int ld = pn < 4 ? CONVD : KVD; const int col0 = (pn < 4 ? pn * 256 : 0) + wc * 32 + 8 * fq;
#pragma unroll
            for (int ai = 0; ai < 2; ++ai)
#pragma unroll
                for (int m = 0; m < 4; ++m) { bf16_t* rowp = base + (size_t)(row0 + ai * HALF + m * 16) * ld + col0;
#pragma unroll
                    for (int bj = 0; bj < 2; ++bj) *(u32x4*)(rowp + bj * HALF) = pack8(acc[ai][bj][m][0], acc[ai][bj][m][1]); }
        } else if (pn < 12) {
            const int col0 = (pn - 4) * 128 + wc * 32 + 8 * fq;
#pragma unroll
            for (int ai = 0; ai < 2; ++ai)
#pragma unroll
                for (int m = 0; m < 4; ++m) { bf16_t* rowp = u + (size_t)(row0 + ai * HALF + m * 16) * CONVD + col0;
                    *(u32x4*)rowp = pack8(acc[ai][0][m][0] * acc[ai][1][m][0], acc[ai][0][m][1] * acc[ai][1][m][1]); }
        } else {
            const bool isq = pn < 16; bf16_t* base = isq ? q : k; const int ld = isq ? ATTD : KVD; const int hc = (isq ? (pn - 12) * 4 : 0) + wc; const float sc = isq ? 0.125f : 1.0f;
#pragma unroll
            for (int ai = 0; ai < 2; ++ai)
#pragma unroll
                for (int m = 0; m < 4; ++m) { const int row = row0 + ai * HALF + m * 16; const float* rp = rope + (size_t)tpos_of_row(row) * 64 + 8 * fq;
                    const f32x4 c0 = *(const f32x4*)rp * sc, c1 = *(const f32x4*)(rp + 4) * sc, s0 = *(const f32x4*)(rp + 32) * sc, s1 = *(const f32x4*)(rp + 36) * sc;
                    const f32x4 x1a = acc[ai][0][m][0], x1b = acc[ai][0][m][1], x2a = acc[ai][1][m][0], x2b = acc[ai][1][m][1];
                    bf16_t* dst = base + (size_t)row * ld + hc * 64 + 8 * fq;
                    *(u32x4*)dst = pack8(x1a * c0 - x2a * s0, x1b * c1 - x2b * s1);
                    *(u32x4*)(dst + 32) = pack8(x2a * c0 + x1a * s0, x2b * c1 + x1b * s1); }
        }
    }
};
struct EpiOut {
    static constexpr bool PERM = false, AFTER_DRAIN = false;
    const float *xp, *xs; float* y; bf16_t* a2; float* ssp;
    __device__ __forceinline__ void operator()(const f32x4 (&acc)[2][2][4][2], const Unit& un, int wr, int wc, int fr, int fq) const {
        const int row0 = un.pm * BM + wr * 64 + fr, col0 = un.pn * BM + wc * 32 + 4 * fq;
#pragma unroll
        for (int ai = 0; ai < 2; ++ai) {
            if (un.pm * BM + ai * HALF >= NREAL) continue;
#pragma unroll
            for (int m = 0; m < 4; ++m) { const int row = row0 + ai * HALF + m * 16;
                const float* xr = (row < MP ? xp + (size_t)row * D : xs + (size_t)(row - MP) * D) + col0;
                float* yr = y + (size_t)row * D + col0; bf16_t* ar = a2 + (size_t)row * D + col0; float ss = 0.f;
#pragma unroll
                for (int bj = 0; bj < 2; ++bj)
#pragma unroll
                    for (int n = 0; n < 2; ++n) { const f32x4 h = *(const f32x4*)(xr + bj * HALF + n * 16) + acc[ai][bj][m][n];
                        *(f32x4*)(yr + bj * HALF + n * 16) = h; *(u32x2*)(ar + bj * HALF + n * 16) = pack4(h);
                        ss += (h[0] * h[0] + h[1] * h[1]) + (h[2] * h[2] + h[3] * h[3]); }
                ss += __shfl_xor(ss, 16); ss += __shfl_xor(ss, 32);
                if (fq == 0) ssp[(size_t)row * 32 + un.pn * 4 + wc] = ss; }
        }
    }
};
struct EpiGU {
    static constexpr bool PERM = true, AFTER_DRAIN = false;
    const float* ssp; bf16_t* hf;
    __device__ __forceinline__ void operator()(const f32x4 (&acc)[2][2][4][2], const Unit& un, int wr, int wc, int fr, int fq) const {
        const int row0 = un.pm * BM + wr * 64 + fr, col0 = un.pn * 128 + wc * 32 + 8 * fq;
#pragma unroll
        for (int ai = 0; ai < 2; ++ai) {
            if (un.pm * BM + ai * HALF >= NREAL) continue;
#pragma unroll
            for (int m = 0; m < 4; ++m) { const int row = row0 + ai * HALF + m * 16;
                const float* sp = ssp + (size_t)row * 32 + fq * 8; const f32x4 pa = *(const f32x4*)sp, pb = *(const f32x4*)(sp + 4);
                float t = ((pa[0] + pa[1]) + (pa[2] + pa[3])) + ((pb[0] + pb[1]) + (pb[2] + pb[3]));
                t += __shfl_xor(t, 16); t += __shfl_xor(t, 32);
                const float rstd = rsqrtf(t * (1.0f / D) + EPS);
                f32x4 h[2];
#pragma unroll
                for (int n = 0; n < 2; ++n) { const f32x4 g = acc[ai][0][m][n] * rstd, uu = acc[ai][1][m][n] * rstd;
#pragma unroll
                    for (int j = 0; j < 4; ++j) h[n][j] = g[j] * uu[j] * __builtin_amdgcn_rcpf(1.0f + __expf(-g[j])); }
                *(u32x4*)(hf + (size_t)row * FF + col0) = pack8(h[0], h[1]); }
        }
    }
};
struct EpiDown {
    static constexpr bool PERM = false, AFTER_DRAIN = false;
    float* y; float* ssp;
    __device__ __forceinline__ void operator()(const f32x4 (&acc)[2][2][4][2], const Unit& un, int wr, int wc, int fr, int fq) const {
        const int row0 = un.pm * BM + wr * 64 + fr, col0 = un.pn * BM + wc * 32 + 4 * fq;
#pragma unroll
        for (int ai = 0; ai < 2; ++ai) {
            if (un.pm * BM + ai * HALF >= NREAL) continue;
#pragma unroll
            for (int m = 0; m < 4; ++m) { const int row = row0 + ai * HALF + m * 16;
                float* yr = y + (size_t)row * D + col0; float ss = 0.f;
#pragma unroll
                for (int bj = 0; bj < 2; ++bj)
#pragma unroll
                    for (int n = 0; n < 2; ++n) { const f32x4 h = *(const f32x4*)(yr + bj * HALF + n * 16) + acc[ai][bj][m][n];
                        *(f32x4*)(yr + bj * HALF + n * 16) = h;
                        ss += (h[0] * h[0] + h[1] * h[1]) + (h[2] * h[2] + h[3] * h[3]); }
                ss += __shfl_xor(ss, 16); ss += __shfl_xor(ss, 32);
                if (fq == 0) ssp[(size_t)row * 32 + un.pn * 4 + wc] = ss; }
        }
    }
};

struct Args { const float* in[18]; float* out; unsigned char* ws; int ph_lo, ph_hi; };
enum { I_XP = 0, I_XS, I_CK, I_CV, I_ST, I_META, I_G1, I_WIN, I_CW, I_CG, I_AG, I_SINK, I_WOUT, I_G2, I_WG, I_WU, I_WD, I_GF };

__device__ __forceinline__ void xpose_weight(const int mode, const float* s0, const float* s1, const int Nsrc, const int K, bf16_t* dst, const int Ndst, const float* kscale, PG8_LAS bf16_t* tile) {
    const int tid = threadIdx.x; const int nkc = K / 256, nG = Ndst / 32; const int nitems = nG * nkc;
    for (int item = blockIdx.x; item < nitems; item += gridDim.x) {
        const int kc = item / nG, G = item % nG;
        const float* src = s0; int sc;
        const int pn = G >> 3, g8 = G & 7, bj = g8 >> 2, hh = g8 & 3;
        if (mode == 0) {
            if (pn < 4) sc = G * 32;
            else if (pn < 12) sc = (bj ? 2048 : 1024) + (pn - 4) * 128 + hh * 32;
            else if (pn < 16) sc = 3072 + ((pn - 12) * 4 + hh) * 64 + bj * 32;
            else if (pn == 16) sc = 4096 + hh * 64 + bj * 32;
            else sc = 4352 + g8 * 32;
        } else if (mode == 1) { sc = G * 32; }
        else { src = bj ? s1 : s0; sc = pn * 128 + hh * 32; }
#pragma unroll
        for (int i = 0; i < 4; ++i) {
            const int idx = tid + i * NTHREADS, r = idx >> 3, c4 = idx & 7; const int kk = kc * 256 + r;
            f32x4 vv = *(const f32x4*)(src + (size_t)kk * Nsrc + sc + c4 * 4);
            if (kscale) vv *= kscale[kk];
            const unsigned p0 = cvt_pk_bf16(vv[0], vv[1]), p1 = cvt_pk_bf16(vv[2], vv[3]);
            tile[(c4 * 4 + 0) * 264 + r] = (bf16_t)(p0 & 0xffffu); tile[(c4 * 4 + 1) * 264 + r] = (bf16_t)(p0 >> 16);
            tile[(c4 * 4 + 2) * 264 + r] = (bf16_t)(p1 & 0xffffu); tile[(c4 * 4 + 3) * 264 + r] = (bf16_t)(p1 >> 16);
        }
        __syncthreads();
#pragma unroll
        for (int i = 0; i < 2; ++i) {
            const int idx = tid + i * NTHREADS, n = idx >> 5, kv = idx & 31;
            const u32x4 w = *(const PG8_LAS u32x4*)(tile + n * 264 + kv * 8);
            *(u32x4*)(dst + (size_t)(G * 32 + n) * K + kc * 256 + kv * 8) = w;
        }
        __syncthreads();
    }
}

__device__ __forceinline__ void p0_prep(const Args& a, PG8_LAS unsigned char* lds) {
    const int tid = threadIdx.x, lane = tid & 63, wid = tid >> 6;
    unsigned char* ws = a.ws;
    PG8_LAS bf16_t* tile = (PG8_LAS bf16_t*)lds;
    {
        bf16_t* hn = (bf16_t*)(ws + WS_HN); const float* g1 = a.in[I_G1];
        for (int row = blockIdx.x * 8 + wid; row < MROWS; row += gridDim.x * 8) {
            bf16_t* dst = hn + (size_t)row * D;
            if (row >= ROW_E) {
#pragma unroll
                for (int i = 0; i < 8; ++i) *(u32x2*)(dst + (i * 64 + lane) * 4) = (u32x2){0u, 0u};
                continue;
            }
            const float* src = row < MP ? a.in[I_XP] + (size_t)row * D : (row < ROW_M ? a.in[I_XS] + (size_t)(row - MP) * D : a.in[I_META] + (size_t)(row - ROW_M) * D);
            f32x4 v[8]; float ss = 0.f;
#pragma unroll
            for (int i = 0; i < 8; ++i) { v[i] = *(const f32x4*)(src + (i * 64 + lane) * 4); ss += (v[i][0] * v[i][0] + v[i][1] * v[i][1]) + (v[i][2] * v[i][2] + v[i][3] * v[i][3]); }
            ss = wave_sum(ss); const float rstd = rsqrtf(ss * (1.0f / D) + EPS);
#pragma unroll
            for (int i = 0; i < 8; ++i) { const f32x4 g = *(const f32x4*)(g1 + (i * 64 + lane) * 4); *(u32x2*)(dst + (i * 64 + lane) * 4) = pack4(v[i] * rstd * g); }
        }
    }
    xpose_weight(0, a.in[I_WIN], nullptr, INC, D, (bf16_t*)(ws + WS_WIN), INC, nullptr, tile);
    xpose_weight(1, a.in[I_WOUT], nullptr, D, D, (bf16_t*)(ws + WS_WOUT), D, nullptr, tile);
    xpose_weight(2, a.in[I_WG], a.in[I_WU], FF, D, (bf16_t*)(ws + WS_WGU), GU, a.in[I_G2], tile);
    xpose_weight(1, a.in[I_WD], nullptr, D, FF, (bf16_t*)(ws + WS_WDN), D, nullptr, tile);
    {
        float* rope = (float*)(ws + WS_ROPE);
        for (int idx = blockIdx.x * NTHREADS + tid; idx < ROPE_ROWS * 32; idx += gridDim.x * NTHREADS) {
            const int tp = idx >> 5, i = idx & 31; const double pos = tp < SEQ + NMETA ? (double)tp : (double)PAST;
            double inv = 1.0; for (int j = 0; j < i; ++j) inv *= 0.7498942093324559;
            double t = pos * inv * 0.15915494309189535; t -= floor(t + 0.5); const double r = t * 6.283185307179586, r2 = r * r;
            double sn = r, cs = 1.0, ts = r, tc = 1.0;
            for (int kq = 1; kq <= 15; ++kq) { tc *= -r2 / (double)((2 * kq - 1) * (2 * kq)); cs += tc; ts *= -r2 / (double)((2 * kq) * (2 * kq + 1)); sn += ts; }
            rope[tp * 64 + i] = (float)cs; rope[tp * 64 + 32 + i] = (float)sn;
        }
    }
    {
        const f32x4* ck = (const f32x4*)a.in[I_CK]; const f32x4* cv = (const f32x4*)a.in[I_CV]; const f32x4* st = (const f32x4*)a.in[I_ST];
        f32x4* oks = (f32x4*)(a.out + OFF_KS); f32x4* ovs = (f32x4*)(a.out + OFF_VS); f32x4* ocs = (f32x4*)(a.out + OFF_CS);
        for (int idx = blockIdx.x * NTHREADS + tid; idx < NS * 127 * 64; idx += gridDim.x * NTHREADS) {
            const int s = idx / (127 * 64), rem = idx - s * (127 * 64);
            oks[(size_t)s * 128 * 64 + rem] = ck[(size_t)s * 128 * 64 + 64 + rem]; ovs[(size_t)s * 128 * 64 + rem] = cv[(size_t)s * 128 * 64 + 64 + rem];
        }
        for (int idx = blockIdx.x * NTHREADS + tid; idx < NS * 256; idx += gridDim.x * NTHREADS) { const int s = idx >> 8, c = idx & 255; ocs[(s * 2) * 256 + c] = st[(s * 2 + 1) * 256 + c]; }
    }
}

#define MFMA32(a, b, c) __builtin_amdgcn_mfma_f32_32x32x16_bf16((a), (b), (c), 0, 0, 0)
constexpr int KS_P = 72, VT_P = 200;
constexpr int L_KS = 0, L_VT = 192 * KS_P * 2, L_SSQ = L_VT + 64 * VT_P * 2, L_SQ = L_SSQ + 64 * 16 * 4, L_SP = L_SQ + 1024 * 4, L_P2END = L_SP + 8 * 2 * 128 * 4;
static_assert(L_P2END <= pg8::STAGE_BYTES, "P2 LDS");

struct ConvCoef { f32x4 w0[4], w1[4], w2[4], g[4]; };
__device__ __forceinline__ void unpack8(const u32x4 p, f32x4& a, f32x4& b) { a = (f32x4){bf_lo(p.x), bf_hi(p.x), bf_lo(p.y), bf_hi(p.y)}; b = (f32x4){bf_lo(p.z), bf_hi(p.z), bf_lo(p.w), bf_hi(p.w)}; }

__device__ __forceinline__ void p2_prompt_item(const Args& a, PG8_LAS unsigned char* lds, const int item) {
    const int tid = threadIdx.x, lane = tid & 63, wid = __builtin_amdgcn_readfirstlane(tid >> 6);
    unsigned char* ws = a.ws;
    const bf16_t* bgp = (const bf16_t*)(ws + WS_BG); const bf16_t* up = (const bf16_t*)(ws + WS_U); const bf16_t* qp = (const bf16_t*)(ws + WS_Q);
    const bf16_t* kp = (const bf16_t*)(ws + WS_K); const bf16_t* vp = (const bf16_t*)(ws + WS_V); bf16_t* mm = (bf16_t*)(ws + WS_M);
    PG8_LAS bf16_t* Ks = (PG8_LAS bf16_t*)(lds + L_KS); PG8_LAS bf16_t* Vt = (PG8_LAS bf16_t*)(lds + L_VT); PG8_LAS float* ssq = (PG8_LAS float*)(lds + L_SSQ);
    const int b = item >> 6, t0 = (item & 63) * 64;
    {
        ConvCoef cf; const float* cw = a.in[I_CW]; const float* cg = a.in[I_CG];
#pragma unroll
        for (int i = 0; i < 2; ++i) { const int c = i * 512 + lane * 8;
#pragma unroll
            for (int h = 0; h < 2; ++h) { cf.w0[i * 2 + h] = *(const f32x4*)(cw + c + 4 * h); cf.w1[i * 2 + h] = *(const f32x4*)(cw + CONVD + c + 4 * h); cf.w2[i * 2 + h] = *(const f32x4*)(cw + 2 * CONVD + c + 4 * h); cf.g[i * 2 + h] = *(const f32x4*)(cg + c + 4 * h); } }
        for (int tt = 0; tt < 8; ++tt) {
            const int t = t0 + wid * 8 + tt, row = b * SEQ + t;
            const int r1 = t >= 1 ? row - 1 : ROW_M + 15, r2 = t >= 2 ? row - 2 : (t == 1 ? ROW_M + 15 : ROW_M + 14);
            f32x4 x[4]; float ss = 0.f;
#pragma unroll
            for (int i = 0; i < 2; ++i) { const int c = i * 512 + lane * 8;
                f32x4 u0a, u0b, u1a, u1b, u2a, u2b, ba, bb;
                unpack8(*(const u32x4*)(up + (size_t)row * CONVD + c), u0a, u0b); unpack8(*(const u32x4*)(up + (size_t)r1 * CONVD + c), u1a, u1b);
                unpack8(*(const u32x4*)(up + (size_t)r2 * CONVD + c), u2a, u2b); unpack8(*(const u32x4*)(bgp + (size_t)row * CONVD + c), ba, bb);
                x[i * 2] = ba * (cf.w0[i * 2] * u2a + cf.w1[i * 2] * u1a + cf.w2[i * 2] * u0a); x[i * 2 + 1] = bb * (cf.w0[i * 2 + 1] * u2b + cf.w1[i * 2 + 1] * u1b + cf.w2[i * 2 + 1] * u0b);
                if (t >= SEQ - 2) { float* o = a.out + OFF_CP + (size_t)(b * 2 + (t - (SEQ - 2))) * CONVD + c; *(f32x4*)o = u0a; *(f32x4*)(o + 4) = u0b; }
            }
#pragma unroll
            for (int e = 0; e < 4; ++e) ss += (x[e][0] * x[e][0] + x[e][1] * x[e][1]) + (x[e][2] * x[e][2] + x[e][3] * x[e][3]);
            ss = wave_sum(ss); const float rstd = rsqrtf(ss * (1.0f / CONVD) + EPS);
#pragma unroll
            for (int i = 0; i < 2; ++i) *(u32x4*)(mm + (size_t)row * D + i * 512 + lane * 8) = pack8(x[i * 2] * rstd * cf.g[i * 2], x[i * 2 + 1] * rstd * cf.g[i * 2 + 1]);
        }
    }
    if (t0 >= SEQ - 128) {
#pragma unroll
        for (int i = 0; i < 4; ++i) { const int idx = tid + i * NTHREADS, tl = idx >> 5, c8 = idx & 31; const int row = b * SEQ + t0 + tl; const size_t o = (size_t)(b * 128 + (t0 + tl - (SEQ - 128))) * KVD + c8 * 8;
            f32x4 x0, x1; unpack8(*(const u32x4*)(kp + (size_t)row * KVD + c8 * 8), x0, x1); *(f32x4*)(a.out + OFF_KP + o) = x0; *(f32x4*)(a.out + OFF_KP + o + 4) = x1;
            unpack8(*(const u32x4*)(vp + (size_t)row * KVD + c8 * 8), x0, x1); *(f32x4*)(a.out + OFF_VP + o) = x0; *(f32x4*)(a.out + OFF_VP + o + 4) = x1; }
    }
    const int P0 = NMETA + t0, c32 = lane & 31, g = lane >> 5, hq = wid & 1, qi = hq * 32 + c32, rowq = b * SEQ + t0 + qi, jmin = 128 - P0;
    const float* sinks = a.in[I_SINK];
    for (int kh = 0; kh < 4; ++kh) {
        __syncthreads();
#pragma unroll
        for (int i = 0; i < 3; ++i) {
            const int idx = tid + i * NTHREADS, j = idx >> 3, c = idx & 7; const int pos = P0 - 128 + j;
            u32x4 kv = {0u, 0u, 0u, 0u}, vv = {0u, 0u, 0u, 0u};
            if (pos >= 0) { const int rk = pos < NMETA ? ROW_M + pos : b * SEQ + pos - NMETA; kv = *(const u32x4*)(kp + (size_t)rk * KVD + kh * 64 + c * 8); vv = *(const u32x4*)(vp + (size_t)rk * KVD + kh * 64 + c * 8); }
            *(PG8_LAS u32x4*)(Ks + j * KS_P + c * 8) = kv;
            PG8_LAS bf16_t* vt = Vt + (c * 8) * VT_P + j;
            vt[0] = (bf16_t)(vv.x & 0xffffu); vt[VT_P] = (bf16_t)(vv.x >> 16); vt[2 * VT_P] = (bf16_t)(vv.y & 0xffffu); vt[3 * VT_P] = (bf16_t)(vv.y >> 16);
            vt[4 * VT_P] = (bf16_t)(vv.z & 0xffffu); vt[5 * VT_P] = (bf16_t)(vv.z >> 16); vt[6 * VT_P] = (bf16_t)(vv.w & 0xffffu); vt[7 * VT_P] = (bf16_t)(vv.w >> 16);
        }
        __syncthreads();
        const int qh = kh * 4 + (wid >> 1);
        bf16x8 Qf[4];
#pragma unroll
        for (int kk = 0; kk < 4; ++kk) Qf[kk] = *(const bf16x8*)(qp + (size_t)rowq * ATTD + qh * 64 + g * 8 + kk * 16);
        f32x16 S[5];
#pragma unroll
        for (int T = 0; T < 5; ++T) {
#pragma unroll
            for (int e = 0; e < 16; ++e) S[T][e] = 0.f;
            const int key = (hq + T) * 32 + c32;
#pragma unroll
            for (int kk = 0; kk < 4; ++kk) { const bf16x8 Kf = *(const PG8_LAS bf16x8*)(Ks + key * KS_P + g * 8 + kk * 16); S[T] = MFMA32(Kf, Qf[kk], S[T]); }
        }
        const float sink = sinks[qh];
        float mx = sink;
#pragma unroll
        for (int T = 0; T < 5; ++T)
#pragma unroll
            for (int e = 0; e < 16; ++e) { const int r = (e & 3) + 8 * (e >> 2) + 4 * g; const int j = (hq + T) * 32 + r;
                bool ok = j >= jmin; if (T == 0) ok = ok && (r >= c32); if (T == 4) ok = ok && (r <= c32);
                const float sv = ok ? S[T][e] : -1e30f; S[T][e] = sv; mx = fmaxf(mx, sv); }
        mx = fmaxf(mx, __shfl_xor(mx, 32));
        float sum = 0.f;
#pragma unroll
        for (int T = 0; T < 5; ++T)
#pragma unroll
            for (int e = 0; e < 16; ++e) { const float p = __expf(S[T][e] - mx); S[T][e] = p; sum += p; }
        sum += __shfl_xor(sum, 32);
        const float inv = 1.0f / (sum + __expf(sink - mx));
        f32x16 O[2];
#pragma unroll
        for (int e = 0; e < 16; ++e) { O[0][e] = 0.f; O[1][e] = 0.f; }
#pragma unroll
        for (int T = 0; T < 5; ++T)
#pragma unroll
            for (int ch = 0; ch < 2; ++ch) {
                u32x4 pw; pw.x = cvt_pk_bf16(S[T][8 * ch + 0], S[T][8 * ch + 1]); pw.y = cvt_pk_bf16(S[T][8 * ch + 2], S[T][8 * ch + 3]); pw.z = cvt_pk_bf16(S[T][8 * ch + 4], S[T][8 * ch + 5]); pw.w = cvt_pk_bf16(S[T][8 * ch + 6], S[T][8 * ch + 7]);
                const bf16x8 Pf = __builtin_bit_cast(bf16x8, pw);
                const int keyb = (hq + T) * 32 + ch * 16 + 4 * g;
#pragma unroll
                for (int dt = 0; dt < 2; ++dt) { const int d = dt * 32 + c32;
                    const u32x2 lo = *(const PG8_LAS u32x2*)(Vt + d * VT_P + keyb), hi = *(const PG8_LAS u32x2*)(Vt + d * VT_P + keyb + 8);
                    const u32x4 vw = {lo.x, lo.y, hi.x, hi.y};
                    O[dt] = MFMA32(__builtin_bit_cast(bf16x8, vw), Pf, O[dt]); }
            }
        float ssl = 0.f;
#pragma unroll
        for (int dt = 0; dt < 2; ++dt)
#pragma unroll
            for (int i4 = 0; i4 < 4; ++i4) { const int d = dt * 32 + 8 * i4 + 4 * g;
                const f32x4 o = (f32x4){O[dt][4 * i4], O[dt][4 * i4 + 1], O[dt][4 * i4 + 2], O[dt][4 * i4 + 3]} * inv;
                *(u32x2*)(mm + (size_t)rowq * D + CONVD + qh * 64 + d) = pack4(o);
                ssl += (o[0] * o[0] + o[1] * o[1]) + (o[2] * o[2] + o[3] * o[3]); }
        ssl += __shfl_xor(ssl, 32);
        if (g == 0) ssq[qi * 16 + qh] = ssl;
    }
    __syncthreads();
    {
        float tot = 0.f;
#pragma unroll
        for (int h4 = 0; h4 < 4; ++h4) { const f32x4 sv = *(const PG8_LAS f32x4*)(ssq + qi * 16 + h4 * 4); tot += (sv[0] + sv[1]) + (sv[2] + sv[3]); }
        const float rstd = rsqrtf(tot * (1.0f / ATTD) + EPS); const float* ag = a.in[I_AG];
        for (int kh = 0; kh < 4; ++kh) { const int qh = kh * 4 + (wid >> 1);
#pragma unroll
            for (int dt = 0; dt < 2; ++dt)
#pragma unroll
                for (int i4 = 0; i4 < 4; ++i4) { const int d = dt * 32 + 8 * i4 + 4 * g; bf16_t* p = mm + (size_t)rowq * D + CONVD + qh * 64 + d;
                    const u32x2 w = *(const u32x2*)p; const f32x4 gv = *(const f32x4*)(ag + qh * 64 + d);
                    const f32x4 o = (f32x4){bf_lo(w.x), bf_hi(w.x), bf_lo(w.y), bf_hi(w.y)} * rstd * gv; *(u32x2*)p = pack4(o); } }
    }
    __syncthreads();
}

__device__ __forceinline__ void p2_sample_item(const Args& a, PG8_LAS unsigned char* lds, const int s) {
    const int tid = threadIdx.x, lane = tid & 63, wid = __builtin_amdgcn_readfirstlane(tid >> 6);
    unsigned char* ws = a.ws;
    const bf16_t* bgp = (const bf16_t*)(ws + WS_BG); const bf16_t* up = (const bf16_t*)(ws + WS_U); const bf16_t* qp = (const bf16_t*)(ws + WS_Q);
    const bf16_t* kp = (const bf16_t*)(ws + WS_K); const bf16_t* vp = (const bf16_t*)(ws + WS_V); bf16_t* mm = (bf16_t*)(ws + WS_M);
    PG8_LAS float* ssq = (PG8_LAS float*)(lds + L_SSQ); PG8_LAS float* sQ = (PG8_LAS float*)(lds + L_SQ); PG8_LAS float* sP = (PG8_LAS float*)(lds + L_SP) + wid * 256;
    const int row = ROW_S + s;
    __syncthreads();
    if (tid < 128) { f32x4 x0, x1; unpack8(*(const u32x4*)(qp + (size_t)row * ATTD + tid * 8), x0, x1); *(PG8_LAS f32x4*)(sQ + tid * 8) = x0; *(PG8_LAS f32x4*)(sQ + tid * 8 + 4) = x1; }
    __syncthreads();
    const int kvh = wid >> 1, h0 = wid * 2;
    float sc[2][2];
    {
        const float* ck = a.in[I_CK] + (size_t)s * 128 * KVD + kvh * 64;
#pragma unroll
        for (int ks = 0; ks < 2; ++ks) { const float* kr = ck + (size_t)(lane + 64 * ks) * KVD; float a0 = 0.f, a1 = 0.f;
#pragma unroll
            for (int d4 = 0; d4 < 16; ++d4) { const f32x4 kv = *(const f32x4*)(kr + d4 * 4); const f32x4 q0 = *(const PG8_LAS f32x4*)(sQ + h0 * 64 + d4 * 4), q1 = *(const PG8_LAS f32x4*)(sQ + (h0 + 1) * 64 + d4 * 4);
                a0 += (kv[0] * q0[0] + kv[1] * q0[1]) + (kv[2] * q0[2] + kv[3] * q0[3]); a1 += (kv[0] * q1[0] + kv[1] * q1[1]) + (kv[2] * q1[2] + kv[3] * q1[3]); }
            sc[ks][0] = a0; sc[ks][1] = a1; }
    }
    const float knew = bf2f(kp[(size_t)row * KVD + kvh * 64 + lane]), vnew = bf2f(vp[(size_t)row * KVD + kvh * 64 + lane]);
    float pnew[2];
#pragma unroll
    for (int hh = 0; hh < 2; ++hh) {
        const float snew = wave_sum(knew * sQ[(h0 + hh) * 64 + lane]); const float sink = a.in[I_SINK][h0 + hh];
        float mx = wave_max(fmaxf(sc[0][hh], sc[1][hh])); mx = fmaxf(mx, fmaxf(snew, sink));
        const float p0 = __expf(sc[0][hh] - mx), p1 = __expf(sc[1][hh] - mx), pn = __expf(snew - mx);
        const float inv = 1.0f / (wave_sum(p0 + p1) + pn + __expf(sink - mx));
        sP[hh * 128 + lane] = p0 * inv; sP[hh * 128 + 64 + lane] = p1 * inv; pnew[hh] = pn * inv;
    }
    __syncthreads();
    float o0 = 0.f, o1 = 0.f;
    {
        const float* cv = a.in[I_CV] + (size_t)s * 128 * KVD + kvh * 64 + lane;
#pragma unroll 8
        for (int j = 0; j < 128; ++j) { const float vv = cv[(size_t)j * KVD]; o0 += sP[j] * vv; o1 += sP[128 + j] * vv; }
    }
    o0 += pnew[0] * vnew; o1 += pnew[1] * vnew;
    const float ss0 = wave_sum(o0 * o0), ss1 = wave_sum(o1 * o1);
    if (lane == 0) { ssq[h0] = ss0; ssq[h0 + 1] = ss1; }
    __syncthreads();
    {
        float tot = 0.f;
#pragma unroll
        for (int h = 0; h < 16; ++h) tot += ssq[h];
        const float rstd = rsqrtf(tot * (1.0f / ATTD) + EPS); const float* ag = a.in[I_AG];
        mm[(size_t)row * D + CONVD + h0 * 64 + lane] = (bf16_t)(cvt_pk_bf16(o0 * rstd * ag[h0 * 64 + lane], 0.f) & 0xffffu);
        mm[(size_t)row * D + CONVD + (h0 + 1) * 64 + lane] = (bf16_t)(cvt_pk_bf16(o1 * rstd * ag[(h0 + 1) * 64 + lane], 0.f) & 0xffffu);
        if ((wid & 1) == 0) { a.out[OFF_KS + (size_t)(s * 128 + 127) * KVD + kvh * 64 + lane] = knew; a.out[OFF_VS + (size_t)(s * 128 + 127) * KVD + kvh * 64 + lane] = vnew; }
    }
    if (wid == 0) {
        const float* cw = a.in[I_CW]; const float* cg = a.in[I_CG]; const float* st = a.in[I_ST] + (size_t)s * 2 * CONVD;
        f32x4 x[4]; float ss = 0.f;
#pragma unroll
        for (int i = 0; i < 2; ++i) { const int c = i * 512 + lane * 8;
            f32x4 u0a, u0b, ba, bb; unpack8(*(const u32x4*)(up + (size_t)row * CONVD + c), u0a, u0b); unpack8(*(const u32x4*)(bgp + (size_t)row * CONVD + c), ba, bb);
            const f32x4 u1a = *(const f32x4*)(st + CONVD + c), u1b = *(const f32x4*)(st + CONVD + c + 4), u2a = *(const f32x4*)(st + c), u2b = *(const f32x4*)(st + c + 4);
            x[i * 2] = ba * (*(const f32x4*)(cw + c) * u2a + *(const f32x4*)(cw + CONVD + c) * u1a + *(const f32x4*)(cw + 2 * CONVD + c) * u0a);
            x[i * 2 + 1] = bb * (*(const f32x4*)(cw + c + 4) * u2b + *(const f32x4*)(cw + CONVD + c + 4) * u1b + *(const f32x4*)(cw + 2 * CONVD + c + 4) * u0b);
            float* o = a.out + OFF_CS + (size_t)(s * 2 + 1) * CONVD + c; *(f32x4*)o = u0a; *(f32x4*)(o + 4) = u0b; }
#pragma unroll
        for (int e = 0; e < 4; ++e) ss += (x[e][0] * x[e][0] + x[e][1] * x[e][1]) + (x[e][2] * x[e][2] + x[e][3] * x[e][3]);
        ss = wave_sum(ss); const float rstd = rsqrtf(ss * (1.0f / CONVD) + EPS);
#pragma unroll
        for (int i = 0; i < 2; ++i) { const int c = i * 512 + lane * 8;
            *(u32x4*)(mm + (size_t)row * D + c) = pack8(x[i * 2] * rstd * *(const f32x4*)(cg + c), x[i * 2 + 1] * rstd * *(const f32x4*)(cg + c + 4)); }
    }
}

__device__ __forceinline__ void p6_final(const Args& a) {
    const int tid = threadIdx.x, lane = tid & 63, wid = tid >> 6;
    const float* ssp = (const float*)(a.ws + WS_SS2); const float* gf = a.in[I_GF];
    for (int row = blockIdx.x * 8 + wid; row < NREAL; row += gridDim.x * 8) {
        float t = lane < 32 ? ssp[(size_t)row * 32 + lane] : 0.f; t = wave_sum(t);
        const float rstd = rsqrtf(t * (1.0f / D) + EPS); float* yr = a.out + (size_t)row * D;
#pragma unroll
        for (int i = 0; i < 8; ++i) { const f32x4 v = *(const f32x4*)(yr + (i * 64 + lane) * 4); const f32x4 g = *(const f32x4*)(gf + (i * 64 + lane) * 4); *(f32x4*)(yr + (i * 64 + lane) * 4) = v * rstd * g; }
    }
}

constexpr int LDS_BYTES = pg8::STAGE_BYTES;
__global__ void __launch_bounds__(NTHREADS, 2) hymba_fwd(Args a) {
    extern __shared__ __attribute__((aligned(16))) unsigned char lds_raw[];
    PG8_LAS unsigned char* lds = (PG8_LAS unsigned char*)lds_raw;
    cg::grid_group grid = cg::this_grid();
    unsigned char* ws = a.ws;
#define IN(k) (a.ph_lo <= (k) && (k) < a.ph_hi)
#define SEAM(k) do { if (IN(k) && IN((k) + 1)) grid.sync(); } while (0)
    if (IN(0)) p0_prep(a, lds);
    SEAM(0);
    if (IN(1)) {
        pg8::Gemm g{(const bf16_t*)(ws + WS_HN), (const bf16_t*)(ws + WS_WIN), MROWS, INC, D}; pg8::StaticOrder S; S.init(MROWS, INC, (int)gridDim.x, (int)blockIdx.x);
        EpiIn E{(bf16_t*)(ws + WS_BG), (bf16_t*)(ws + WS_U), (bf16_t*)(ws + WS_Q), (bf16_t*)(ws + WS_K), (bf16_t*)(ws + WS_V), (const float*)(ws + WS_ROPE)};
        pg8::gemm_phase<EpiIn, pg8::StaticOrder>(lds, g, S, E);
    }
    SEAM(1);
    if (IN(2)) {
        for (int item = blockIdx.x; item < 256 + NS; item += gridDim.x) { if (item < 256) p2_prompt_item(a, lds, item); else p2_sample_item(a, lds, item - 256); }
    }
    SEAM(2);
    if (IN(3)) {
        pg8::Gemm g{(const bf16_t*)(ws + WS_M), (const bf16_t*)(ws + WS_WOUT), MROWS, D, D}; pg8::StaticOrder S; S.init(MROWS, D, (int)gridDim.x, (int)blockIdx.x);
        EpiOut E{a.in[I_XP], a.in[I_XS], a.out, (bf16_t*)(ws + WS_HN), (float*)(ws + WS_SS1)};
        pg8::gemm_phase<EpiOut, pg8::StaticOrder>(lds, g, S, E);
    }
    SEAM(3);
    if (IN(4)) {
        pg8::Gemm g{(const bf16_t*)(ws + WS_HN), (const bf16_t*)(ws + WS_WGU), MROWS, GU, D}; pg8::StaticOrder S; S.init(MROWS, GU, (int)gridDim.x, (int)blockIdx.x);
        EpiGU E{(const float*)(ws + WS_SS1), (bf16_t*)(ws + WS_HF)};
        pg8::gemm_phase<EpiGU, pg8::StaticOrder>(lds, g, S, E);
    }
    SEAM(4);
    if (IN(5)) {
        pg8::Gemm g{(const bf16_t*)(ws + WS_HF), (const bf16_t*)(ws + WS_WDN), MROWS, D, FF}; pg8::StaticOrder S; S.init(MROWS, D, (int)gridDim.x, (int)blockIdx.x);
        EpiDown E{a.out, (float*)(ws + WS_SS2)};
        pg8::gemm_phase<EpiDown, pg8::StaticOrder>(lds, g, S, E);
    }
    SEAM(5);
    if (IN(6)) p6_final(a);
#undef IN
#undef SEAM
}

#ifndef ONE_LAUNCH
#define ONE_LAUNCH 1
#endif
extern "C" void kernel_launch(void* const* d_in, const int* in_sizes, int n_in, void* d_out, int out_size, void* d_ws, size_t ws_size, hipStream_t stream) {
    static int grid = 0;
    if (grid == 0) {
        if (n_in != 18 || (size_t)out_size != OUT_TOTAL || ws_size < WS_END) { fprintf(stderr, "kernel_launch: unexpected shapes: n_in %d out %d ws %zu (need %zu)\n", n_in, out_size, ws_size, (size_t)WS_END); grid = -1; return; }
        int dev = 0, cus = 0, per_cu = 0;
        (void)hipGetDevice(&dev); (void)hipDeviceGetAttribute(&cus, hipDeviceAttributeMultiprocessorCount, dev);
        if (hipFuncSetAttribute((const void*)hymba_fwd, hipFuncAttributeMaxDynamicSharedMemorySize, LDS_BYTES) != hipSuccess) { fprintf(stderr, "kernel_launch: hipFuncSetAttribute failed\n"); grid = -1; return; }
        if (hipOccupancyMaxActiveBlocksPerMultiprocessor(&per_cu, (const void*)hymba_fwd, NTHREADS, LDS_BYTES) != hipSuccess || per_cu < 1) { fprintf(stderr, "kernel_launch: occupancy query says %d blocks per CU\n", per_cu); grid = -1; return; }
        grid = cus;
    }
    if (grid < 0) return;
    Args a{};
    for (int i = 0; i < 18; ++i) a.in[i] = (const float*)d_in[i];
    a.out = (float*)d_out; a.ws = (unsigned char*)d_ws;
#if ONE_LAUNCH
    a.ph_lo = 0; a.ph_hi = 7;
    void* args[] = {&a};
    hipError_t e = hipLaunchCooperativeKernel((const void*)hymba_fwd, dim3(grid), dim3(NTHREADS), args, LDS_BYTES, stream);
    if (e != hipSuccess) fprintf(stderr, "cooperative launch failed: %s (grid %d)\n", hipGetErrorString(e), grid);
#else
    for (int ph = 0; ph < 7; ++ph) { a.ph_lo = ph; a.ph_hi = ph + 1; hipLaunchKernelGGL(hymba_fwd, dim3(grid), dim3(NTHREADS), LDS_BYTES, stream, a); }
#endif
}
```

```cpp
#include <hip/hip_runtime.h>
#include <hip/hip_cooperative_groups.h>
#include <cstdio>
namespace cg = cooperative_groups;

#define PG8_LAS __attribute__((address_space(3)))
typedef unsigned short bf16_t;
typedef short bf16x8 __attribute__((ext_vector_type(8)));
typedef float f32x4 __attribute__((ext_vector_type(4)));
typedef float f32x16 __attribute__((ext_vector_type(16)));
typedef unsigned u32x4 __attribute__((ext_vector_type(4)));
typedef unsigned u32x2 __attribute__((ext_vector_type(2)));

constexpr int D = 2048, SEQ = 4096, NB = 4, NS = 128, NMETA = 16;
constexpr int MP = NB * SEQ;
constexpr int ROW_S = MP;
constexpr int ROW_M = MP + NS;
constexpr int ROW_E = ROW_M + NMETA;
constexpr int MROWS = 16640;
constexpr int NREAL = ROW_M;
constexpr int CONVD = 1024, ATTD = 1024, KVD = 256, HD = 64;
constexpr int INC = 4608, FF = 5632, GU = 2 * FF;
constexpr int NTHREADS = 512;
constexpr int PAST = 16384;
constexpr float EPS = 1e-6f;
constexpr int ROPE_ROWS = SEQ + NMETA + 1;

constexpr size_t OFF_Y = 0;
constexpr size_t OFF_KP = (size_t)(MP + NS) * D;
constexpr size_t OFF_VP = OFF_KP + (size_t)NB * 128 * KVD;
constexpr size_t OFF_CP = OFF_VP + (size_t)NB * 128 * KVD;
constexpr size_t OFF_KS = OFF_CP + (size_t)NB * 2 * CONVD;
constexpr size_t OFF_VS = OFF_KS + (size_t)NS * 128 * KVD;
constexpr size_t OFF_CS = OFF_VS + (size_t)NS * 128 * KVD;
constexpr size_t OUT_TOTAL = OFF_CS + (size_t)NS * 2 * CONVD;

constexpr size_t WS_WIN = 0;
constexpr size_t WS_WOUT = WS_WIN + (size_t)INC * D * 2;
constexpr size_t WS_WGU = WS_WOUT + (size_t)D * D * 2;
constexpr size_t WS_WDN = WS_WGU + (size_t)GU * D * 2;
constexpr size_t WS_HN = WS_WDN + (size_t)D * FF * 2;
constexpr size_t WS_C = WS_HN + (size_t)MROWS * D * 2;
constexpr size_t WS_BG = WS_C;
constexpr size_t WS_U = WS_BG + (size_t)MROWS * CONVD * 2;
constexpr size_t WS_Q = WS_U + (size_t)MROWS * CONVD * 2;
constexpr size_t WS_K = WS_Q + (size_t)MROWS * ATTD * 2;
constexpr size_t WS_V = WS_K + (size_t)MROWS * KVD * 2;
constexpr size_t WS_M = WS_V + (size_t)MROWS * KVD * 2;
constexpr size_t WS_HF = WS_C;
constexpr size_t WS_CEND = WS_C + (size_t)MROWS * FF * 2;
static_assert(WS_M + (size_t)MROWS * D * 2 <= WS_CEND, "region C");
constexpr size_t WS_ROPE = WS_CEND;
constexpr size_t WS_SS1 = WS_ROPE + (size_t)ROPE_ROWS * 64 * 4;
constexpr size_t WS_SS2 = WS_SS1 + (size_t)MROWS * 32 * 4;
constexpr size_t WS_SSS1 = WS_SS2 + (size_t)MROWS * 32 * 4;
constexpr size_t WS_SSS2 = WS_SSS1 + (size_t)NS * 128 * 4;
constexpr size_t WS_HP2 = WS_SSS2 + (size_t)NS * 128 * 4;
constexpr size_t WS_END = WS_HP2 + (size_t)MROWS * D * 2;

__device__ __forceinline__ unsigned cvt_pk_bf16(float lo, float hi) { unsigned r; asm volatile("v_cvt_pk_bf16_f32 %0, %1, %2" : "=v"(r) : "v"(lo), "v"(hi)); return r; }
__device__ __forceinline__ float bf_lo(unsigned u) { return __uint_as_float(u << 16); }
__device__ __forceinline__ float bf_hi(unsigned u) { return __uint_as_float(u & 0xffff0000u); }
__device__ __forceinline__ float bf2f(bf16_t x) { return __uint_as_float((unsigned)x << 16); }
__device__ __forceinline__ float wave_sum(float v) {
#pragma unroll
    for (int o = 32; o >= 1; o >>= 1) v += __shfl_xor(v, o);
    return v;
}
__device__ __forceinline__ float wave_max(float v) {
#pragma unroll
    for (int o = 32; o >= 1; o >>= 1) v = fmaxf(v, __shfl_xor(v, o));
    return v;
}
__device__ __forceinline__ int tpos_of_row(int row) { return row < MP ? NMETA + (row & (SEQ - 1)) : (row < ROW_M ? (SEQ + NMETA) : (row < ROW_E ? row - ROW_M : 0)); }

namespace pg8 {
constexpr int BM = 256, BK = 64, HALF = 128, HTB = HALF * BK * 2  , STAGE_BYTES = 8 * HTB, NXCD = 8, WGM = 8;
__host__ __device__ __forceinline__ int lds_byte(int r, int c) { const int st = (r >> 4) * 2 + (c >> 5), rr = r & 15, cc = c & 31, ob = rr * 64 + cc * 2; return st * 1024 + (ob ^ (((ob >> 9) & 1) << 5)); }
__host__ __device__ __forceinline__ void stage_rc(int b, int& R, int& C) { const int st = b / 1024, sb = b % 1024, swz = sb ^ (((sb >> 9) & 1) << 5); R = (st >> 1) * 16 + swz / 64; C = (st & 1) * 32 + (swz % 64) / 2; }
__host__ __device__ __forceinline__ int perm32(int rho) { const int n = rho >> 4, i = rho & 15; return 8 * (i >> 2) + 4 * n + (i & 3); }

struct Unit { int pm, pn; };
struct Gemm { const bf16_t* A; const bf16_t* Bt; int M, N, K; };

struct StaticOrder {
    int nM, nN, nwg, G, c;
    __host__ __device__ void init(int M, int N, int G_, int c_) { nM = M / BM; nN = N / BM; nwg = nM * nN; G = G_; c = c_; }
    __host__ __device__ bool next(int i, Unit& u) const {
        const long L = (long)i * G + c; if (L >= nwg) return false;
        int wgid = (int)L; { const int q = nwg / NXCD, r = nwg % NXCD, xcd = wgid % NXCD, off = wgid / NXCD; wgid = (xcd < r ? xcd * (q + 1) : r * (q + 1) + (xcd - r) * q) + off; }
        const int nig = WGM * nN, gid = wgid / nig, fm = gid * WGM, gsz = (nM - fm) < WGM ? (nM - fm) : WGM;
        u.pm = fm + ((wgid % nig) % gsz); u.pn = (wgid % nig) / gsz; return true;
    }
    __device__ __forceinline__ void a_ready(const Unit&) const {}
    __device__ __forceinline__ void done(const Unit&) const {}
};

template <class Epi, class Sched>
__device__ __forceinline__ void gemm_phase(PG8_LAS unsigned char* lds, const Gemm g, const Sched& S, const Epi& E) {
    const int tid = threadIdx.x, wid = __builtin_amdgcn_readfirstlane(tid >> 6), lane = tid & 63, wr = wid >> 2, wc = wid & 3, fr = lane & 15, fq = lane >> 4;
    const int K = g.K, nt = K / BK;
    unsigned voffA[2], voffB[2];
#pragma unroll
    for (int i = 0; i < 2; ++i) { int R, C; stage_rc(tid * 16 + i * 8192, R, C); const int Rb = Epi::PERM ? ((R & ~31) + perm32(R & 31)) : R;
        voffA[i] = (unsigned)(R * K + C) * 2u; voffB[i] = (unsigned)(Rb * K + C) * 2u; }
    const size_t kstep = (size_t)(BK * 2);
    const size_t hstep = (size_t)HALF * K * 2;
    const size_t tstep = 2 * hstep;
    const unsigned ldsw = (unsigned)wid * 1024u;
    const int aoff = lds_byte(wr * 64 + fr, fq * 8), boff = lds_byte(wc * 32 + fr, fq * 8);
#define PG8_SA(b, h) (((b) * 2 + (h)) * HTB)
#define PG8_SB(b, h) ((4 + (b) * 2 + (h)) * HTB)
#define PG8_STAGE(bufoff, gbase, voff) do { _Pragma("unroll") for (int _i = 0; _i < 2; ++_i) \
        __builtin_amdgcn_global_load_lds((const unsigned*)((const char*)(gbase) + (voff)[_i]), (PG8_LAS unsigned*)(lds + (bufoff) + ldsw + _i * 8192), 16, 0, 0); } while (0)
#define PG8_LDA(dst, b, h) do { _Pragma("unroll") for (int m = 0; m < 4; ++m) _Pragma("unroll") for (int k = 0; k < 2; ++k) dst[m][k] = *(const PG8_LAS bf16x8*)(lds + PG8_SA(b, h) + aoff + m * 2048 + k * 1024); } while (0)
#define PG8_LDB(dst, b, h) do { _Pragma("unroll") for (int n = 0; n < 2; ++n) _Pragma("unroll") for (int k = 0; k < 2; ++k) dst[n][k] = *(const PG8_LAS bf16x8*)(lds + PG8_SB(b, h) + boff + n * 2048 + k * 1024); } while (0)
#define PG8_MMA(ai, bj, At, Bt) do { __builtin_amdgcn_s_setprio(1); _Pragma("unroll") for (int m = 0; m < 4; ++m) _Pragma("unroll") for (int n = 0; n < 2; ++n) _Pragma("unroll") for (int k = 0; k < 2; ++k) \
        acc[ai][bj][m][n] = __builtin_amdgcn_mfma_f32_16x16x32_bf16(Bt[n][k], At[m][k], acc[ai][bj][m][n], 0, 0, 0); __builtin_amdgcn_s_setprio(0); } while (0)
#define PG8_WAIT_V(n) asm volatile("s_waitcnt vmcnt(" #n ")" ::: "memory")
#define PG8_WAIT_L(n) asm volatile("s_waitcnt lgkmcnt(" #n ")" ::: "memory")
#define PG8_BAR __builtin_amdgcn_s_barrier()
#define PG8_SCHED __builtin_amdgcn_sched_barrier(0)
    Unit cur, nxt; int ui = 0;
    if (!S.next(0, cur)) return;
    f32x4 acc[2][2][4][2];
#pragma unroll
    for (int a = 0; a < 2; ++a)
#pragma unroll
        for (int b = 0; b < 2; ++b)
#pragma unroll
            for (int m = 0; m < 4; ++m)
#pragma unroll
                for (int n = 0; n < 2; ++n) acc[a][b][m][n] = (f32x4){0.f, 0.f, 0.f, 0.f};
    bf16x8 At[4][2], B0[2][2], B1[2][2];
    const char* cA = (const char*)g.A + (size_t)cur.pm * tstep; const char* cB = (const char*)g.Bt + (size_t)cur.pn * tstep;
    S.a_ready(cur);
    PG8_STAGE(PG8_SB(0, 0), cB, voffB); PG8_STAGE(PG8_SA(0, 0), cA, voffA); PG8_STAGE(PG8_SB(0, 1), cB + hstep, voffB); PG8_STAGE(PG8_SA(0, 1), cA + hstep, voffA);
    if (wr == 1) PG8_BAR;
    PG8_WAIT_V(4); PG8_BAR;
    PG8_STAGE(PG8_SB(1, 0), cB + kstep, voffB); PG8_STAGE(PG8_SA(1, 0), cA + kstep, voffA); PG8_STAGE(PG8_SB(1, 1), cB + hstep + kstep, voffB);
    PG8_WAIT_V(6); PG8_BAR;
    for (;;) {
        const bool has_next = S.next(ui + 1, nxt);
        const char* nA = has_next ? (const char*)g.A + (size_t)nxt.pm * tstep : cA; const char* nB = has_next ? (const char*)g.Bt + (size_t)nxt.pn * tstep : cB;
        for (int t = 0; t < nt; t += 2) {
            const bool last = (t == nt - 2);
            const char* a1 = cA + (size_t)(t + 1) * kstep;
            const char* a2 = last ? nA : cA + (size_t)(t + 2) * kstep; const char* b2 = last ? nB : cB + (size_t)(t + 2) * kstep;
            const char* a3 = a2 + kstep; const char* b3 = b2 + kstep;
            if (last && has_next) S.a_ready(nxt);
            PG8_LDB(B0, 0, 0); PG8_SCHED; PG8_LDA(At, 0, 0); PG8_STAGE(PG8_SA(1, 1), a1 + hstep, voffA);
            PG8_WAIT_L(8); PG8_BAR; PG8_WAIT_L(0); PG8_MMA(0, 0, At, B0); PG8_BAR; PG8_SCHED;
            PG8_LDB(B1, 0, 1); PG8_STAGE(PG8_SB(0, 0), b2, voffB);
            PG8_BAR; PG8_WAIT_L(0); PG8_MMA(0, 1, At, B1); PG8_BAR;
            PG8_LDA(At, 0, 1); PG8_STAGE(PG8_SA(0, 0), a2, voffA);
            PG8_BAR; PG8_WAIT_L(0); PG8_MMA(1, 0, At, B0); PG8_BAR; PG8_SCHED;
            PG8_STAGE(PG8_SB(0, 1), b2 + hstep, voffB);
            PG8_WAIT_V(6); PG8_BAR; PG8_MMA(1, 1, At, B1); PG8_BAR;
            PG8_LDB(B0, 1, 0); PG8_SCHED; PG8_LDA(At, 1, 0); PG8_STAGE(PG8_SA(0, 1), a2 + hstep, voffA);
            PG8_WAIT_L(8); PG8_BAR; PG8_WAIT_L(0); PG8_MMA(0, 0, At, B0); PG8_BAR; PG8_SCHED;
            PG8_LDB(B1, 1, 1); PG8_STAGE(PG8_SB(1, 0), b3, voffB);
            PG8_BAR; PG8_WAIT_L(0); PG8_MMA(0, 1, At, B1); PG8_BAR;
            PG8_LDA(At, 1, 1); PG8_STAGE(PG8_SA(1, 0), a3, voffA);
            PG8_BAR; PG8_WAIT_L(0); PG8_MMA(1, 0, At, B0); PG8_BAR; PG8_SCHED;
            PG8_STAGE(PG8_SB(1, 1), b3 + hstep, voffB);
            PG8_WAIT_V(6); PG8_BAR; PG8_MMA(1, 1, At, B1); PG8_BAR;
        }
        if constexpr (!Epi::AFTER_DRAIN) { E(acc, cur, wr, wc, fr, fq); S.done(cur); }
        if (!has_next) break;
#pragma unroll
        for (int a = 0; a < 2; ++a)
#pragma unroll
            for (int b = 0; b < 2; ++b)
#pragma unroll
                for (int m = 0; m < 4; ++m)
#pragma unroll
                    for (int n = 0; n < 2; ++n) acc[a][b][m][n] = (f32x4){0.f, 0.f, 0.f, 0.f};
        cur = nxt; cA = nA; cB = nB; ++ui;
    }
    PG8_WAIT_V(0);
    if (wr == 0) PG8_BAR;
    PG8_BAR;
    if constexpr (Epi::AFTER_DRAIN) { E.fused(acc, cur, wr, wc, fr, fq, lds, wid, lane); S.done(cur); }
#undef PG8_SA
#undef PG8_SB
#undef PG8_STAGE
#undef PG8_LDA
#undef PG8_LDB
#undef PG8_MMA
#undef PG8_WAIT_V
#undef PG8_WAIT_L
#undef PG8_BAR
#undef PG8_SCHED
}
}
using pg8::Unit; using pg8::BM; using pg8::HALF;

__device__ __forceinline__ u32x4 pack8(const f32x4 a, const f32x4 b) { u32x4 w; w.x = cvt_pk_bf16(a[0], a[1]); w.y = cvt_pk_bf16(a[2], a[3]); w.z = cvt_pk_bf16(b[0], b[1]); w.w = cvt_pk_bf16(b[2], b[3]); return w; }
__device__ __forceinline__ u32x2 pack4(const f32x4 a) { u32x2 w; w.x = cvt_pk_bf16(a[0], a[1]); w.y = cvt_pk_bf16(a[2], a[3]); return w; }

struct EpiIn {
    static constexpr bool PERM = true, AFTER_DRAIN = false;
    bf16_t *bg, *u, *q, *k, *v; const float* rope;
    __device__ __forceinline__ void operator()(const f32x4 (&acc)[2][2][4][2], const Unit& un, int wr, int wc, int fr, int fq) const {
        const int row0 = un.pm * BM + wr * 64 + fr, pn = un.pn;
        if (pn < 4 || pn == 17) {
            bf16_t* base = pn < 4 ? bg : v; const int ld = pn < 4 ? CONVD : KVD; const int col0 = (pn < 4 ? pn * 256 : 0) + wc * 32 + 8 * fq;
#pragma unroll
            for (int ai = 0; ai < 2; ++ai)
#pragma unroll
                for (int m = 0; m < 4; ++m) { bf16_t* rowp = base + (size_t)(row0 + ai * HALF + m * 16) * ld + col0;
#pragma unroll
                    for (int bj = 0; bj < 2; ++bj) *(u32x4*)(rowp + bj * HALF) = pack8(acc[ai][bj][m][0], acc[ai][bj][m][1]); }
        } else if (pn < 12) {
            const int col0 = (pn - 4) * 128 + wc * 32 + 8 * fq;
#pragma unroll
            for (int ai = 0; ai < 2; ++ai)
#pragma unroll
                for (int m = 0; m < 4; ++m) { bf16_t* rowp = u + (size_t)(row0 + ai * HALF + m * 16) * CONVD + col0;
                    *(u32x4*)rowp = pack8(acc[ai][0][m][0] * acc[ai][1][m][0], acc[ai][0][m][1] * acc[ai][1][m][1]); }
        } else {
            const bool isq = pn < 16; bf16_t* base = isq ? q : k; const int ld = isq ? ATTD : KVD; const int hc = (isq ? (pn - 12) * 4 : 0) + wc; const float sc = isq ? 0.125f : 1.0f;
#pragma unroll
            for (int ai = 0; ai < 2; ++ai)
#pragma unroll
                for (int m = 0; m < 4; ++m) { const int row = row0 + ai * HALF + m * 16; const float* rp = rope + (size_t)tpos_of_row(row) * 64 + 8 * fq;
                    const f32x4 c0 = *(const f32x4*)rp * sc, c1 = *(const f32x4*)(rp + 4) * sc, s0 = *(const f32x4*)(rp + 32) * sc, s1 = *(const f32x4*)(rp + 36) * sc;
                    const f32x4 x1a = acc[ai][0][m][0], x1b = acc[ai][0][m][1], x2a = acc[ai][1][m][0], x2b = acc[ai][1][m][1];
                    bf16_t* dst = base + (size_t)row * ld + hc * 64 + 8 * fq;
                    *(u32x4*)dst = pack8(x1a * c0 - x2a * s0, x1b * c1 - x2b * s1);
                    *(u32x4*)(dst + 32) = pack8(x2a * c0 + x1a * s0, x2b * c1 + x1b * s1); }
        }
    }
};
struct EpiOut {
    static constexpr bool PERM = false, AFTER_DRAIN = false;
    const float* xp; bf16_t* a2; float* ssp;
    __device__ __forceinline__ void operator()(const f32x4 (&acc)[2][2][4][2], const Unit& un, int wr, int wc, int fr, int fq) const {
        const int row0 = un.pm * BM + wr * 64 + fr, col0 = un.pn * BM + wc * 32 + 4 * fq;
#pragma unroll
        for (int ai = 0; ai < 2; ++ai) {
#pragma unroll
            for (int m = 0; m < 4; ++m) { const int row = row0 + ai * HALF + m * 16;
                const float* xr = xp + (size_t)row * D + col0; bf16_t* ar = a2 + (size_t)row * D + col0; float ss = 0.f;
#pragma unroll
                for (int bj = 0; bj < 2; ++bj)
#pragma unroll
                    for (int n = 0; n < 2; ++n) { const f32x4 h = *(const f32x4*)(xr + bj * HALF + n * 16) + acc[ai][bj][m][n];
                        *(u32x2*)(ar + bj * HALF + n * 16) = pack4(h);
                        ss += (h[0] * h[0] + h[1] * h[1]) + (h[2] * h[2] + h[3] * h[3]); }
                ss += __shfl_xor(ss, 16); ss += __shfl_xor(ss, 32);
                if (fq == 0) ssp[(size_t)row * 32 + un.pn * 4 + wc] = ss; }
        }
    }
};
struct EpiGU {
    static constexpr bool PERM = true, AFTER_DRAIN = false;
    const float* ssp; bf16_t* hf;
    __device__ __forceinline__ void operator()(const f32x4 (&acc)[2][2][4][2], const Unit& un, int wr, int wc, int fr, int fq) const {
        const int row0 = un.pm * BM + wr * 64 + fr, col0 = un.pn * 128 + wc * 32 + 8 * fq;
#pragma unroll
        for (int ai = 0; ai < 2; ++ai) {
#pragma unroll
            for (int m = 0; m < 4; ++m) { const int row = row0 + ai * HALF + m * 16;
                const float* sp = ssp + (size_t)row * 32 + fq * 8; const f32x4 pa = *(const f32x4*)sp, pb = *(const f32x4*)(sp + 4);
                float t = ((pa[0] + pa[1]) + (pa[2] + pa[3])) + ((pb[0] + pb[1]) + (pb[2] + pb[3]));
                t += __shfl_xor(t, 16); t += __shfl_xor(t, 32);
                const float rstd = rsqrtf(t * (1.0f / D) + EPS);
                f32x4 h[2];
#pragma unroll
                for (int n = 0; n < 2; ++n) { const f32x4 g = acc[ai][0][m][n] * rstd, uu = acc[ai][1][m][n] * rstd;
#pragma unroll
                    for (int j = 0; j < 4; ++j) h[n][j] = g[j] * uu[j] * __builtin_amdgcn_rcpf(1.0f + __expf(-g[j])); }
                *(u32x4*)(hf + (size_t)row * FF + col0) = pack8(h[0], h[1]); }
        }
    }
};
struct EpiDown {
    static constexpr bool PERM = false, AFTER_DRAIN = false;
    const bf16_t* a2; bf16_t* hp2; float* ssp;
    __device__ __forceinline__ void operator()(const f32x4 (&acc)[2][2][4][2], const Unit& un, int wr, int wc, int fr, int fq) const {
        const int row0 = un.pm * BM + wr * 64 + fr, col0 = un.pn * BM + wc * 32 + 4 * fq;
#pragma unroll
        for (int ai = 0; ai < 2; ++ai) {
#pragma unroll
            for (int m = 0; m < 4; ++m) { const int row = row0 + ai * HALF + m * 16;
                const bf16_t* ar = a2 + (size_t)row * D + col0; bf16_t* hr = hp2 + (size_t)row * D + col0; float ss = 0.f;
#pragma unroll
                for (int bj = 0; bj < 2; ++bj)
#pragma unroll
                    for (int n = 0; n < 2; ++n) { const u32x2 w = *(const u32x2*)(ar + bj * HALF + n * 16);
                        const f32x4 h = (f32x4){bf_lo(w.x), bf_hi(w.x), bf_lo(w.y), bf_hi(w.y)} + acc[ai][bj][m][n];
                        *(u32x2*)(hr + bj * HALF + n * 16) = pack4(h);
                        ss += (h[0] * h[0] + h[1] * h[1]) + (h[2] * h[2] + h[3] * h[3]); }
                ss += __shfl_xor(ss, 16); ss += __shfl_xor(ss, 32);
                if (fq == 0) ssp[(size_t)row * 32 + un.pn * 4 + wc] = ss; }
        }
    }
};

#define MFMA16(a, b, c) __builtin_amdgcn_mfma_f32_16x16x32_bf16((a), (b), (c), 0, 0, 0)
template <int NG, class Epi>
__device__ __forceinline__ void skinny_gemm(const bf16_t* A, const bf16_t* Bt, const int K, const int nitems, const Epi& E, PG8_LAS unsigned char* lds) {
    const int tid = threadIdx.x, lane = tid & 63, wid = tid >> 6, fr = lane & 15, fq = lane >> 4;
    const int kw = K >> 3; const bf16_t* ap = A + (size_t)fr * K + wid * kw + fq * 8;
    PG8_LAS f32x4* red = (PG8_LAS f32x4*)lds;
    for (int item = blockIdx.x; item < nitems; item += gridDim.x) {
        const bf16_t* bp[NG]; f32x4 acc[NG][8];
#pragma unroll
        for (int g = 0; g < NG; ++g) { bp[g] = Bt + (size_t)(E.brow(item, g) + fr) * K + wid * kw + fq * 8;
#pragma unroll
            for (int rg = 0; rg < 8; ++rg) acc[g][rg] = (f32x4){0.f, 0.f, 0.f, 0.f}; }
        constexpr int SB = 2;
#pragma unroll 1
        for (int k0 = 0; k0 < kw; k0 += 32 * SB) {
            bf16x8 bv[SB][NG], av[SB][8];
#pragma unroll
            for (int st = 0; st < SB; ++st) {
#pragma unroll
                for (int g = 0; g < NG; ++g) bv[st][g] = *(const bf16x8*)(bp[g] + k0 + st * 32);
#pragma unroll
                for (int rg = 0; rg < 8; ++rg) av[st][rg] = *(const bf16x8*)(ap + (size_t)(rg * 16) * K + k0 + st * 32);
            }
#pragma unroll
            for (int st = 0; st < SB; ++st)
#pragma unroll
                for (int g = 0; g < NG; ++g)
#pragma unroll
                    for (int rg = 0; rg < 8; ++rg) acc[g][rg] = MFMA16(bv[st][g], av[st][rg], acc[g][rg]);
        }
#pragma unroll
        for (int g = 0; g < NG; ++g)
#pragma unroll
            for (int rg = 0; rg < 8; ++rg) red[((wid * NG + g) * 8 + rg) * 64 + lane] = acc[g][rg];
        __syncthreads();
        f32x4 fin[NG];
#pragma unroll
        for (int g = 0; g < NG; ++g) { fin[g] = red[((0 * NG + g) * 8 + wid) * 64 + lane];
#pragma unroll
            for (int w2 = 1; w2 < 8; ++w2) fin[g] += red[((w2 * NG + g) * 8 + wid) * 64 + lane]; }
        E(fin, item, wid * 16 + fr, fq);
        __syncthreads();
    }
}
struct SkOut {
    const float* xs; bf16_t* a2; float* ssS;
    __device__ __forceinline__ int brow(int item, int) const { return item * 16; }
    __device__ __forceinline__ void operator()(const f32x4 (&acc)[1], int item, int r, int fq) const {
        const int c = item * 16 + 4 * fq; const f32x4 h = *(const f32x4*)(xs + (size_t)r * D + c) + acc[0];
        *(u32x2*)(a2 + (size_t)(ROW_S + r) * D + c) = pack4(h);
        float ss = (h[0] * h[0] + h[1] * h[1]) + (h[2] * h[2] + h[3] * h[3]); ss += __shfl_xor(ss, 16); ss += __shfl_xor(ss, 32);
        if (fq == 0) ssS[r * 128 + item] = ss;
    }
};
struct SkGU {
    bf16_t* hf; float rstd;
    __device__ __forceinline__ int brow(int item, int g) const { return (item >> 3) * 256 + (item & 7) * 16 + g * 128; }
    __device__ __forceinline__ void operator()(const f32x4 (&acc)[2], int item, int r, int fq) const {
        const f32x4 g = acc[0] * rstd, uu = acc[1] * rstd; f32x4 h;
#pragma unroll
        for (int j = 0; j < 4; ++j) h[j] = g[j] * uu[j] * __builtin_amdgcn_rcpf(1.0f + __expf(-g[j]));
        *(u32x2*)(hf + (size_t)(ROW_S + r) * FF + item * 16 + 4 * fq) = pack4(h);
    }
};
struct SkDown {
    const bf16_t* a2; bf16_t* hp2; float* ssS;
    __device__ __forceinline__ int brow(int item, int) const { return item * 16; }
    __device__ __forceinline__ void operator()(const f32x4 (&acc)[1], int item, int r, int fq) const {
        const int c = item * 16 + 4 * fq; const u32x2 w = *(const u32x2*)(a2 + (size_t)(ROW_S + r) * D + c);
        const f32x4 h = (f32x4){bf_lo(w.x), bf_hi(w.x), bf_lo(w.y), bf_hi(w.y)} + acc[0];
        *(u32x2*)(hp2 + (size_t)(ROW_S + r) * D + c) = pack4(h);
        float ss = (h[0] * h[0] + h[1] * h[1]) + (h[2] * h[2] + h[3] * h[3]); ss += __shfl_xor(ss, 16); ss += __shfl_xor(ss, 32);
        if (fq == 0) ssS[r * 128 + item] = ss;
    }
};

struct Args { const float* in[18]; float* out; unsigned char* ws; int ph_lo, ph_hi; };
enum { I_XP = 0, I_XS, I_CK, I_CV, I_ST, I_META, I_G1, I_WIN, I_CW, I_CG, I_AG, I_SINK, I_WOUT, I_G2, I_WG, I_WU, I_WD, I_GF };

__device__ __forceinline__ void xpose_weight(const int mode, const float* s0, const float* s1, const int Nsrc, const int K, bf16_t* dst, const int Ndst, const float* kscale, PG8_LAS bf16_t* tile) {
    const int tid = threadIdx.x; const int nkc = K / 256, nG = Ndst / 32; const int nitems = nG * nkc;
    for (int item = blockIdx.x; item < nitems; item += gridDim.x) {
        const int kc = item / nG, G = item % nG;
        const float* src = s0; int sc;
        const int pn = G >> 3, g8 = G & 7, bj = g8 >> 2, hh = g8 & 3;
        if (mode == 0) {
            if (pn < 4) sc = G * 32;
            else if (pn < 12) sc = (bj ? 2048 : 1024) + (pn - 4) * 128 + hh * 32;
            else if (pn < 16) sc = 3072 + ((pn - 12) * 4 + hh) * 64 + bj * 32;
            else if (pn == 16) sc = 4096 + hh * 64 + bj * 32;
            else sc = 4352 + g8 * 32;
        } else if (mode == 1) { sc = G * 32; }
        else { src = bj ? s1 : s0; sc = pn * 128 + hh * 32; }
#pragma unroll
        for (int i = 0; i < 4; ++i) {
            const int idx = tid + i * NTHREADS, r = idx >> 3, c4 = idx & 7; const int kk = kc * 256 + r;
            f32x4 vv = *(const f32x4*)(src + (size_t)kk * Nsrc + sc + c4 * 4);
            if (kscale) vv *= kscale[kk];
            const unsigned p0 = cvt_pk_bf16(vv[0], vv[1]), p1 = cvt_pk_bf16(vv[2], vv[3]);
            tile[(c4 * 4 + 0) * 264 + r] = (bf16_t)(p0 & 0xffffu); tile[(c4 * 4 + 1) * 264 + r] = (bf16_t)(p0 >> 16);
            tile[(c4 * 4 + 2) * 264 + r] = (bf16_t)(p1 & 0xffffu); tile[(c4 * 4 + 3) * 264 + r] = (bf16_t)(p1 >> 16);
        }
        __syncthreads();
#pragma unroll
        for (int i = 0; i < 2; ++i) {
            const int idx = tid + i * NTHREADS, n = idx >> 5, kv = idx & 31;
            const u32x4 w = *(const PG8_LAS u32x4*)(tile + n * 264 + kv * 8);
            *(u32x4*)(dst + (size_t)(G * 32 + n) * K + kc * 256 + kv * 8) = w;
        }
        __syncthreads();
    }
}

__device__ __forceinline__ void p0_prep(const Args& a, PG8_LAS unsigned char* lds) {
    const int tid = threadIdx.x, lane = tid & 63, wid = tid >> 6;
    unsigned char* ws = a.ws;
    PG8_LAS bf16_t* tile = (PG8_LAS bf16_t*)lds;
    {
        bf16_t* hn = (bf16_t*)(ws + WS_HN); const float* g1 = a.in[I_G1];
        for (int row = blockIdx.x * 8 + wid; row < MROWS; row += gridDim.x * 8) {
            bf16_t* dst = hn + (size_t)row * D;
            if (row >= ROW_E) {
#pragma unroll
                for (int i = 0; i < 8; ++i) *(u32x2*)(dst + (i * 64 + lane) * 4) = (u32x2){0u, 0u};
                continue;
            }
            const float* src = row < MP ? a.in[I_XP] + (size_t)row * D : (row < ROW_M ? a.in[I_XS] + (size_t)(row - MP) * D : a.in[I_META] + (size_t)(row - ROW_M) * D);
            f32x4 v[8]; float ss = 0.f;
#pragma unroll
            for (int i = 0; i < 8; ++i) { v[i] = *(const f32x4*)(src + (i * 64 + lane) * 4); ss += (v[i][0] * v[i][0] + v[i][1] * v[i][1]) + (v[i][2] * v[i][2] + v[i][3] * v[i][3]); }
            ss = wave_sum(ss); const float rstd = rsqrtf(ss * (1.0f / D) + EPS);
#pragma unroll
            for (int i = 0; i < 8; ++i) { const f32x4 g = *(const f32x4*)(g1 + (i * 64 + lane) * 4); *(u32x2*)(dst + (i * 64 + lane) * 4) = pack4(v[i] * rstd * g); }
        }
    }
    xpose_weight(0, a.in[I_WIN], nullptr, INC, D, (bf16_t*)(ws + WS_WIN), INC, nullptr, tile);
    xpose_weight(1, a.in[I_WOUT], nullptr, D, D, (bf16_t*)(ws + WS_WOUT), D, nullptr, tile);
    xpose_weight(2, a.in[I_WG], a.in[I_WU], FF, D, (bf16_t*)(ws + WS_WGU), GU, a.in[I_G2], tile);
    xpose_weight(1, a.in[I_WD], nullptr, D, FF, (bf16_t*)(ws + WS_WDN), D, nullptr, tile);
    {
        float* rope = (float*)(ws + WS_ROPE);
        for (int idx = blockIdx.x * NTHREADS + tid; idx < ROPE_ROWS * 32; idx += gridDim.x * NTHREADS) {
            const int tp = idx >> 5, i = idx & 31; const double pos = tp < SEQ + NMETA ? (double)tp : (double)PAST;
            double inv = 1.0; for (int j = 0; j < i; ++j) inv *= 0.7498942093324559;
            double t = pos * inv * 0.15915494309189535; t -= floor(t + 0.5); const double r = t * 6.283185307179586, r2 = r * r;
            double sn = r, cs = 1.0, ts = r, tc = 1.0;
            for (int kq = 1; kq <= 15; ++kq) { tc *= -r2 / (double)((2 * kq - 1) * (2 * kq)); cs += tc; ts *= -r2 / (double)((2 * kq) * (2 * kq + 1)); sn += ts; }
            rope[tp * 64 + i] = (float)cs; rope[tp * 64 + 32 + i] = (float)sn;
        }
    }
    {
        const f32x4* ck = (const f32x4*)a.in[I_CK]; const f32x4* cv = (const f32x4*)a.in[I_CV]; const f32x4* st = (const f32x4*)a.in[I_ST];
        f32x4* oks = (f32x4*)(a.out + OFF_KS); f32x4* ovs = (f32x4*)(a.out + OFF_VS); f32x4* ocs = (f32x4*)(a.out + OFF_CS);
        for (int idx = blockIdx.x * NTHREADS + tid; idx < NS * 127 * 64; idx += gridDim.x * NTHREADS) {
            const int s = idx / (127 * 64), rem = idx - s * (127 * 64);
            oks[(size_t)s * 128 * 64 + rem] = ck[(size_t)s * 128 * 64 + 64 + rem]; ovs[(size_t)s * 128 * 64 + rem] = cv[(size_t)s * 128 * 64 + 64 + rem];
        }
        for (int idx = blockIdx.x * NTHREADS + tid; idx < NS * 256; idx += gridDim.x * NTHREADS) { const int s = idx >> 8, c = idx & 255; ocs[(s * 2) * 256 + c] = st[(s * 2 + 1) * 256 + c]; }
    }
}

#define MFMA32(a, b, c) __builtin_amdgcn_mfma_f32_32x32x16_bf16((a), (b), (c), 0, 0, 0)
constexpr int KS_P = 72, VT_P = 200;
constexpr int L_KS = 0, L_VT = 192 * KS_P * 2, L_SSQ = L_VT + 64 * VT_P * 2, L_SQ = L_SSQ + 64 * 16 * 4, L_SP = L_SQ + 1024 * 4, L_P2END = L_SP + 8 * 2 * 128 * 4;
static_assert(L_P2END <= pg8::STAGE_BYTES, "P2 LDS");

struct ConvCoef { f32x4 w0[4], w1[4], w2[4], g[4]; };
__device__ __forceinline__ void unpack8(const u32x4 p, f32x4& a, f32x4& b) { a = (f32x4){bf_lo(p.x), bf_hi(p.x), bf_lo(p.y), bf_hi(p.y)}; b = (f32x4){bf_lo(p.z), bf_hi(p.z), bf_lo(p.w), bf_hi(p.w)}; }

__device__ __forceinline__ void p2_prompt_item(const Args& a, PG8_LAS unsigned char* lds, const int item) {
    const int tid = threadIdx.x, lane = tid & 63, wid = __builtin_amdgcn_readfirstlane(tid >> 6);
    unsigned char* ws = a.ws;
    const bf16_t* bgp = (const bf16_t*)(ws + WS_BG); const bf16_t* up = (const bf16_t*)(ws + WS_U); const bf16_t* qp = (const bf16_t*)(ws + WS_Q);
    const bf16_t* kp = (const bf16_t*)(ws + WS_K); const bf16_t* vp = (const bf16_t*)(ws + WS_V); bf16_t* mm = (bf16_t*)(ws + WS_M);
    PG8_LAS bf16_t* Ks = (PG8_LAS bf16_t*)(lds + L_KS); PG8_LAS bf16_t* Vt = (PG8_LAS bf16_t*)(lds + L_VT); PG8_LAS float* ssq = (PG8_LAS float*)(lds + L_SSQ);
    const int b = item >> 6, t0 = (item & 63) * 64;
    {
        ConvCoef cf; const float* cw = a.in[I_CW]; const float* cg = a.in[I_CG];
#pragma unroll
        for (int i = 0; i < 2; ++i) { const int c = i * 512 + lane * 8;
#pragma unroll
            for (int h = 0; h < 2; ++h) { cf.w0[i * 2 + h] = *(const f32x4*)(cw + c + 4 * h); cf.w1[i * 2 + h] = *(const f32x4*)(cw + CONVD + c + 4 * h); cf.w2[i * 2 + h] = *(const f32x4*)(cw + 2 * CONVD + c + 4 * h); cf.g[i * 2 + h] = *(const f32x4*)(cg + c + 4 * h); } }
        for (int tt = 0; tt < 8; ++tt) {
            const int t = t0 + wid * 8 + tt, row = b * SEQ + t;
            const int r1 = t >= 1 ? row - 1 : ROW_M + 15, r2 = t >= 2 ? row - 2 : (t == 1 ? ROW_M + 15 : ROW_M + 14);
            f32x4 x[4]; float ss = 0.f;
#pragma unroll
            for (int i = 0; i < 2; ++i) { const int c = i * 512 + lane * 8;
                f32x4 u0a, u0b, u1a, u1b, u2a, u2b, ba, bb;
                unpack8(*(const u32x4*)(up + (size_t)row * CONVD + c), u0a, u0b); unpack8(*(const u32x4*)(up + (size_t)r1 * CONVD + c), u1a, u1b);
                unpack8(*(const u32x4*)(up + (size_t)r2 * CONVD + c), u2a, u2b); unpack8(*(const u32x4*)(bgp + (size_t)row * CONVD + c), ba, bb);
                x[i * 2] = ba * (cf.w0[i * 2] * u2a + cf.w1[i * 2] * u1a + cf.w2[i * 2] * u0a); x[i * 2 + 1] = bb * (cf.w0[i * 2 + 1] * u2b + cf.w1[i * 2 + 1] * u1b + cf.w2[i * 2 + 1] * u0b);
                if (t >= SEQ - 2) { float* o = a.out + OFF_CP + (size_t)(b * 2 + (t - (SEQ - 2))) * CONVD + c; *(f32x4*)o = u0a; *(f32x4*)(o + 4) = u0b; }
            }
#pragma unroll
            for (int e = 0; e < 4; ++e) ss += (x[e][0] * x[e][0] + x[e][1] * x[e][1]) + (x[e][2] * x[e][2] + x[e][3] * x[e][3]);
            ss = wave_sum(ss); const float rstd = rsqrtf(ss * (1.0f / CONVD) + EPS);
#pragma unroll
            for (int i = 0; i < 2; ++i) *(u32x4*)(mm + (size_t)row * D + i * 512 + lane * 8) = pack8(x[i * 2] * rstd * cf.g[i * 2], x[i * 2 + 1] * rstd * cf.g[i * 2 + 1]);
        }
    }
    if (t0 >= SEQ - 128) {
#pragma unroll
        for (int i = 0; i < 4; ++i) { const int idx = tid + i * NTHREADS, tl = idx >> 5, c8 = idx & 31; const int row = b * SEQ + t0 + tl; const size_t o = (size_t)(b * 128 + (t0 + tl - (SEQ - 128))) * KVD + c8 * 8;
            f32x4 x0, x1; unpack8(*(const u32x4*)(kp + (size_t)row * KVD + c8 * 8), x0, x1); *(f32x4*)(a.out + OFF_KP + o) = x0; *(f32x4*)(a.out + OFF_KP + o + 4) = x1;
            unpack8(*(const u32x4*)(vp + (size_t)row * KVD + c8 * 8), x0, x1); *(f32x4*)(a.out + OFF_VP + o) = x0; *(f32x4*)(a.out + OFF_VP + o + 4) = x1; }
    }
    const int P0 = NMETA + t0, c32 = lane & 31, g = lane >> 5, hq = wid & 1, qi = hq * 32 + c32, rowq = b * SEQ + t0 + qi, jmin = 128 - P0;
    const float* sinks = a.in[I_SINK];
    for (int kh = 0; kh < 4; ++kh) {
        __syncthreads();
#pragma unroll
        for (int i = 0; i < 3; ++i) {
            const int idx = tid + i * NTHREADS, j = idx >> 3, c = idx & 7; const int pos = P0 - 128 + j;
            u32x4 kv = {0u, 0u, 0u, 0u}, vv = {0u, 0u, 0u, 0u};
            if (pos >= 0) { const int rk = pos < NMETA ? ROW_M + pos : b * SEQ + pos - NMETA; kv = *(const u32x4*)(kp + (size_t)rk * KVD + kh * 64 + c * 8); vv = *(const u32x4*)(vp + (size_t)rk * KVD + kh * 64 + c * 8); }
            *(PG8_LAS u32x4*)(Ks + j * KS_P + c * 8) = kv;
            PG8_LAS bf16_t* vt = Vt + (c * 8) * VT_P + j;
            vt[0] = (bf16_t)(vv.x & 0xffffu); vt[VT_P] = (bf16_t)(vv.x >> 16); vt[2 * VT_P] = (bf16_t)(vv.y & 0xffffu); vt[3 * VT_P] = (bf16_t)(vv.y >> 16);
            vt[4 * VT_P] = (bf16_t)(vv.z & 0xffffu); vt[5 * VT_P] = (bf16_t)(vv.z >> 16); vt[6 * VT_P] = (bf16_t)(vv.w & 0xffffu); vt[7 * VT_P] = (bf16_t)(vv.w >> 16);
        }
        __syncthreads();
        const int qh = kh * 4 + (wid >> 1);
        bf16x8 Qf[4];
#pragma unroll
        for (int kk = 0; kk < 4; ++kk) Qf[kk] = *(const bf16x8*)(qp + (size_t)rowq * ATTD + qh * 64 + g * 8 + kk * 16);
        f32x16 S[5];
#pragma unroll
        for (int T = 0; T < 5; ++T) {
#pragma unroll
            for (int e = 0; e < 16; ++e) S[T][e] = 0.f;
            const int key = (hq + T) * 32 + c32;
#pragma unroll
            for (int kk = 0; kk < 4; ++kk) { const bf16x8 Kf = *(const PG8_LAS bf16x8*)(Ks + key * KS_P + g * 8 + kk * 16); S[T] = MFMA32(Kf, Qf[kk], S[T]); }
        }
        const float sink = sinks[qh];
        float mx = sink;
#pragma unroll
        for (int T = 0; T < 5; ++T)
#pragma unroll
            for (int e = 0; e < 16; ++e) { const int r = (e & 3) + 8 * (e >> 2) + 4 * g; const int j = (hq + T) * 32 + r;
                bool ok = j >= jmin; if (T == 0) ok = ok && (r >= c32); if (T == 4) ok = ok && (r <= c32);
                const float sv = ok ? S[T][e] : -1e30f; S[T][e] = sv; mx = fmaxf(mx, sv); }
        mx = fmaxf(mx, __shfl_xor(mx, 32));
        float sum = 0.f;
#pragma unroll
        for (int T = 0; T < 5; ++T)
#pragma unroll
            for (int e = 0; e < 16; ++e) { const float p = __expf(S[T][e] - mx); S[T][e] = p; sum += p; }
        sum += __shfl_xor(sum, 32);
        const float inv = 1.0f / (sum + __expf(sink - mx));
        f32x16 O[2];
#pragma unroll
        for (int e = 0; e < 16; ++e) { O[0][e] = 0.f; O[1][e] = 0.f; }
#pragma unroll
        for (int T = 0; T < 5; ++T)
#pragma unroll
            for (int ch = 0; ch < 2; ++ch) {
                u32x4 pw; pw.x = cvt_pk_bf16(S[T][8 * ch + 0], S[T][8 * ch + 1]); pw.y = cvt_pk_bf16(S[T][8 * ch + 2], S[T][8 * ch + 3]); pw.z = cvt_pk_bf16(S[T][8 * ch + 4], S[T][8 * ch + 5]); pw.w = cvt_pk_bf16(S[T][8 * ch + 6], S[T][8 * ch + 7]);
                const bf16x8 Pf = __builtin_bit_cast(bf16x8, pw);
                const int keyb = (hq + T) * 32 + ch * 16 + 4 * g;
#pragma unroll
                for (int dt = 0; dt < 2; ++dt) { const int d = dt * 32 + c32;
                    const u32x2 lo = *(const PG8_LAS u32x2*)(Vt + d * VT_P + keyb), hi = *(const PG8_LAS u32x2*)(Vt + d * VT_P + keyb + 8);
                    const u32x4 vw = {lo.x, lo.y, hi.x, hi.y};
                    O[dt] = MFMA32(__builtin_bit_cast(bf16x8, vw), Pf, O[dt]); }
            }
        float ssl = 0.f;
#pragma unroll
        for (int dt = 0; dt < 2; ++dt)
#pragma unroll
            for (int i4 = 0; i4 < 4; ++i4) { const int d = dt * 32 + 8 * i4 + 4 * g;
                const f32x4 o = (f32x4){O[dt][4 * i4], O[dt][4 * i4 + 1], O[dt][4 * i4 + 2], O[dt][4 * i4 + 3]} * inv;
                *(u32x2*)(mm + (size_t)rowq * D + CONVD + qh * 64 + d) = pack4(o);
                ssl += (o[0] * o[0] + o[1] * o[1]) + (o[2] * o[2] + o[3] * o[3]); }
        ssl += __shfl_xor(ssl, 32);
        if (g == 0) ssq[qi * 16 + qh] = ssl;
    }
    __syncthreads();
    {
        float tot = 0.f;
#pragma unroll
        for (int h4 = 0; h4 < 4; ++h4) { const f32x4 sv = *(const PG8_LAS f32x4*)(ssq + qi * 16 + h4 * 4); tot += (sv[0] + sv[1]) + (sv[2] + sv[3]); }
        const float rstd = rsqrtf(tot * (1.0f / ATTD) + EPS); const float* ag = a.in[I_AG];
        for (int kh = 0; kh < 4; ++kh) { const int qh = kh * 4 + (wid >> 1);
#pragma unroll
            for (int dt = 0; dt < 2; ++dt)
#pragma unroll
                for (int i4 = 0; i4 < 4; ++i4) { const int d = dt * 32 + 8 * i4 + 4 * g; bf16_t* p = mm + (size_t)rowq * D + CONVD + qh * 64 + d;
                    const u32x2 w = *(const u32x2*)p; const f32x4 gv = *(const f32x4*)(ag + qh * 64 + d);
                    const f32x4 o = (f32x4){bf_lo(w.x), bf_hi(w.x), bf_lo(w.y), bf_hi(w.y)} * rstd * gv; *(u32x2*)p = pack4(o); } }
    }
    __syncthreads();
}

__device__ __forceinline__ void p2_sample_item(const Args& a, PG8_LAS unsigned char* lds, const int s) {
    const int tid = threadIdx.x, lane = tid & 63, wid = __builtin_amdgcn_readfirstlane(tid >> 6);
    unsigned char* ws = a.ws;
    const bf16_t* bgp = (const bf16_t*)(ws + WS_BG); const bf16_t* up = (const bf16_t*)(ws + WS_U); const bf16_t* qp = (const bf16_t*)(ws + WS_Q);
    const bf16_t* kp = (const bf16_t*)(ws + WS_K); const bf16_t* vp = (const bf16_t*)(ws + WS_V); bf16_t* mm = (bf16_t*)(ws + WS_M);
    PG8_LAS float* ssq = (PG8_LAS float*)(lds + L_SSQ); PG8_LAS float* sQ = (PG8_LAS float*)(lds + L_SQ); PG8_LAS float* sP = (PG8_LAS float*)(lds + L_SP) + wid * 256;
    const int row = ROW_S + s;
    __syncthreads();
    if (tid < 128) { f32x4 x0, x1; unpack8(*(const u32x4*)(qp + (size_t)row * ATTD + tid * 8), x0, x1); *(PG8_LAS f32x4*)(sQ + tid * 8) = x0; *(PG8_LAS f32x4*)(sQ + tid * 8 + 4) = x1; }
    __syncthreads();
    const int kvh = wid >> 1, h0 = wid * 2;
    float sc[2][2];
    {
        const float* ck = a.in[I_CK] + (size_t)s * 128 * KVD + kvh * 64;
#pragma unroll
        for (int ks = 0; ks < 2; ++ks) { const float* kr = ck + (size_t)(lane + 64 * ks) * KVD; float a0 = 0.f, a1 = 0.f;
#pragma unroll
            for (int d4 = 0; d4 < 16; ++d4) { const f32x4 kv = *(const f32x4*)(kr + d4 * 4); const f32x4 q0 = *(const PG8_LAS f32x4*)(sQ + h0 * 64 + d4 * 4), q1 = *(const PG8_LAS f32x4*)(sQ + (h0 + 1) * 64 + d4 * 4);
                a0 += (kv[0] * q0[0] + kv[1] * q0[1]) + (kv[2] * q0[2] + kv[3] * q0[3]); a1 += (kv[0] * q1[0] + kv[1] * q1[1]) + (kv[2] * q1[2] + kv[3] * q1[3]); }
            sc[ks][0] = a0; sc[ks][1] = a1; }
    }
    const float knew = bf2f(kp[(size_t)row * KVD + kvh * 64 + lane]), vnew = bf2f(vp[(size_t)row * KVD + kvh * 64 + lane]);
    float pnew[2];
#pragma unroll
    for (int hh = 0; hh < 2; ++hh) {
        const float snew = wave_sum(knew * sQ[(h0 + hh) * 64 + lane]); const float sink = a.in[I_SINK][h0 + hh];
        float mx = wave_max(fmaxf(sc[0][hh], sc[1][hh])); mx = fmaxf(mx, fmaxf(snew, sink));
        const float p0 = __expf(sc[0][hh] - mx), p1 = __expf(sc[1][hh] - mx), pn = __expf(snew - mx);
        const float inv = 1.0f / (wave_sum(p0 + p1) + pn + __expf(sink - mx));
        sP[hh * 128 + lane] = p0 * inv; sP[hh * 128 + 64 + lane] = p1 * inv; pnew[hh] = pn * inv;
    }
    __syncthreads();
    float o0 = 0.f, o1 = 0.f;
    {
        const float* cv = a.in[I_CV] + (size_t)s * 128 * KVD + kvh * 64 + lane;
#pragma unroll 8
        for (int j = 0; j < 128; ++j) { const float vv = cv[(size_t)j * KVD]; o0 += sP[j] * vv; o1 += sP[128 + j] * vv; }
    }
    o0 += pnew[0] * vnew; o1 += pnew[1] * vnew;
    const float ss0 = wave_sum(o0 * o0), ss1 = wave_sum(o1 * o1);
    if (lane == 0) { ssq[h0] = ss0; ssq[h0 + 1] = ss1; }
    __syncthreads();
    {
        float tot = 0.f;
#pragma unroll
        for (int h = 0; h < 16; ++h) tot += ssq[h];
        const float rstd = rsqrtf(tot * (1.0f / ATTD) + EPS); const float* ag = a.in[I_AG];
        mm[(size_t)row * D + CONVD + h0 * 64 + lane] = (bf16_t)(cvt_pk_bf16(o0 * rstd * ag[h0 * 64 + lane], 0.f) & 0xffffu);
        mm[(size_t)row * D + CONVD + (h0 + 1) * 64 + lane] = (bf16_t)(cvt_pk_bf16(o1 * rstd * ag[(h0 + 1) * 64 + lane], 0.f) & 0xffffu);
        if ((wid & 1) == 0) { a.out[OFF_KS + (size_t)(s * 128 + 127) * KVD + kvh * 64 + lane] = knew; a.out[OFF_VS + (size_t)(s * 128 + 127) * KVD + kvh * 64 + lane] = vnew; }
    }
    if (wid == 0) {
        const float* cw = a.in[I_CW]; const float* cg = a.in[I_CG]; const float* st = a.in[I_ST] + (size_t)s * 2 * CONVD;
        f32x4 x[4]; float ss = 0.f;
#pragma unroll
        for (int i = 0; i < 2; ++i) { const int c = i * 512 + lane * 8;
            f32x4 u0a, u0b, ba, bb; unpack8(*(const u32x4*)(up + (size_t)row * CONVD + c), u0a, u0b); unpack8(*(const u32x4*)(bgp + (size_t)row * CONVD + c), ba, bb);
            const f32x4 u1a = *(const f32x4*)(st + CONVD + c), u1b = *(const f32x4*)(st + CONVD + c + 4), u2a = *(const f32x4*)(st + c), u2b = *(const f32x4*)(st + c + 4);
            x[i * 2] = ba * (*(const f32x4*)(cw + c) * u2a + *(const f32x4*)(cw + CONVD + c) * u1a + *(const f32x4*)(cw + 2 * CONVD + c) * u0a);
            x[i * 2 + 1] = bb * (*(const f32x4*)(cw + c + 4) * u2b + *(const f32x4*)(cw + CONVD + c + 4) * u1b + *(const f32x4*)(cw + 2 * CONVD + c + 4) * u0b);
            float* o = a.out + OFF_CS + (size_t)(s * 2 + 1) * CONVD + c; *(f32x4*)o = u0a; *(f32x4*)(o + 4) = u0b; }
#pragma unroll
        for (int e = 0; e < 4; ++e) ss += (x[e][0] * x[e][0] + x[e][1] * x[e][1]) + (x[e][2] * x[e][2] + x[e][3] * x[e][3]);
        ss = wave_sum(ss); const float rstd = rsqrtf(ss * (1.0f / CONVD) + EPS);
#pragma unroll
        for (int i = 0; i < 2; ++i) { const int c = i * 512 + lane * 8;
            *(u32x4*)(mm + (size_t)row * D + c) = pack8(x[i * 2] * rstd * *(const f32x4*)(cg + c), x[i * 2 + 1] * rstd * *(const f32x4*)(cg + c + 4)); }
    }
}

__device__ __forceinline__ void p6_final(const Args& a) {
    const int tid = threadIdx.x, lane = tid & 63, wid = tid >> 6;
    const float* ssp = (const float*)(a.ws + WS_SS2); const float* ssS = (const float*)(a.ws + WS_SSS2); const float* gf = a.in[I_GF]; const bf16_t* hp2 = (const bf16_t*)(a.ws + WS_HP2);
    for (int row = blockIdx.x * 8 + wid; row < NREAL; row += gridDim.x * 8) {
        float t = row < MP ? (lane < 32 ? ssp[(size_t)row * 32 + lane] : 0.f) : ssS[(row - MP) * 128 + lane] + ssS[(row - MP) * 128 + 64 + lane];
        t = wave_sum(t);
        const float rstd = rsqrtf(t * (1.0f / D) + EPS); float* yr = a.out + (size_t)row * D; const bf16_t* hr = hp2 + (size_t)row * D;
#pragma unroll
        for (int i = 0; i < 4; ++i) { const int c = (i * 64 + lane) * 8; f32x4 x0, x1; unpack8(*(const u32x4*)(hr + c), x0, x1);
            *(f32x4*)(yr + c) = x0 * rstd * *(const f32x4*)(gf + c); *(f32x4*)(yr + c + 4) = x1 * rstd * *(const f32x4*)(gf + c + 4); }
    }
}

constexpr int LDS_BYTES = pg8::STAGE_BYTES;
__global__ void __launch_bounds__(NTHREADS, 2) hymba_fwd(Args a) {
    extern __shared__ __attribute__((aligned(16))) unsigned char lds_raw[];
    PG8_LAS unsigned char* lds = (PG8_LAS unsigned char*)lds_raw;
    cg::grid_group grid = cg::this_grid();
    unsigned char* ws = a.ws;
#ifndef PROBE_REP
#define PROBE_REP -1
#endif
#define NREP(k) ((k) == PROBE_REP ? 2 : 1)
#define IN(k) (a.ph_lo <= (k) && (k) < a.ph_hi)
#define SEAM(k) do { if (IN(k) && IN((k) + 1)) grid.sync(); } while (0)
    if (IN(0)) for (int rep = 0; rep < NREP(0); ++rep) { if (rep) grid.sync(); p0_prep(a, lds); }
    SEAM(0);
    if (IN(1)) for (int rep = 0; rep < NREP(1); ++rep) { if (rep) grid.sync();
        pg8::Gemm g{(const bf16_t*)(ws + WS_HN), (const bf16_t*)(ws + WS_WIN), MROWS, INC, D}; pg8::StaticOrder S; S.init(MROWS, INC, (int)gridDim.x, (int)blockIdx.x);
        EpiIn E{(bf16_t*)(ws + WS_BG), (bf16_t*)(ws + WS_U), (bf16_t*)(ws + WS_Q), (bf16_t*)(ws + WS_K), (bf16_t*)(ws + WS_V), (const float*)(ws + WS_ROPE)};
        pg8::gemm_phase<EpiIn, pg8::StaticOrder>(lds, g, S, E);
    }
    SEAM(1);
    if (IN(2)) for (int rep = 0; rep < NREP(2); ++rep) { if (rep) grid.sync();
        for (int item = blockIdx.x; item < 256 + NS; item += gridDim.x) { if (item < 256) p2_prompt_item(a, lds, item); else p2_sample_item(a, lds, item - 256); }
    }
    SEAM(2);
    if (IN(3)) for (int rep = 0; rep < NREP(3); ++rep) { if (rep) grid.sync();
        { SkOut E{a.in[I_XS], (bf16_t*)(ws + WS_HN), (float*)(ws + WS_SSS1)};
          skinny_gemm<1, SkOut>((const bf16_t*)(ws + WS_M) + (size_t)ROW_S * D, (const bf16_t*)(ws + WS_WOUT), D, D / 16, E, lds); }
        pg8::Gemm g{(const bf16_t*)(ws + WS_M), (const bf16_t*)(ws + WS_WOUT), MP, D, D}; pg8::StaticOrder S; S.init(MP, D, (int)gridDim.x, (int)blockIdx.x);
        EpiOut E{a.in[I_XP], (bf16_t*)(ws + WS_HN), (float*)(ws + WS_SS1)};
        pg8::gemm_phase<EpiOut, pg8::StaticOrder>(lds, g, S, E);
    }
    SEAM(3);
    if (IN(4)) for (int rep = 0; rep < NREP(4); ++rep) { if (rep) grid.sync();
        { const int lane = threadIdx.x & 63, r = (threadIdx.x >> 6) * 16 + (lane & 15), fq = lane >> 4; const float* sp = (const float*)(ws + WS_SSS1) + r * 128 + fq * 32; float t = 0.f;
#pragma unroll
          for (int i = 0; i < 8; ++i) { const f32x4 v = *(const f32x4*)(sp + 4 * i); t += (v[0] + v[1]) + (v[2] + v[3]); }
          t += __shfl_xor(t, 16); t += __shfl_xor(t, 32);
          SkGU E{(bf16_t*)(ws + WS_HF), rsqrtf(t * (1.0f / D) + EPS)};
          skinny_gemm<2, SkGU>((const bf16_t*)(ws + WS_HN) + (size_t)ROW_S * D, (const bf16_t*)(ws + WS_WGU), D, FF / 16, E, lds); }
        pg8::Gemm g{(const bf16_t*)(ws + WS_HN), (const bf16_t*)(ws + WS_WGU), MP, GU, D}; pg8::StaticOrder S; S.init(MP, GU, (int)gridDim.x, (int)blockIdx.x);
        EpiGU E{(const float*)(ws + WS_SS1), (bf16_t*)(ws + WS_HF)};
        pg8::gemm_phase<EpiGU, pg8::StaticOrder>(lds, g, S, E);
    }
    SEAM(4);
    if (IN(5)) for (int rep = 0; rep < NREP(5); ++rep) { if (rep) grid.sync();
        { SkDown E{(const bf16_t*)(ws + WS_HN), (bf16_t*)(ws + WS_HP2), (float*)(ws + WS_SSS2)};
          skinny_gemm<1, SkDown>((const bf16_t*)(ws + WS_HF) + (size_t)ROW_S * FF, (const bf16_t*)(ws + WS_WDN), FF, D / 16, E, lds); }
        pg8::Gemm g{(const bf16_t*)(ws + WS_HF), (const bf16_t*)(ws + WS_WDN), MP, D, FF}; pg8::StaticOrder S; S.init(MP, D, (int)gridDim.x, (int)blockIdx.x);
        EpiDown E{(const bf16_t*)(ws + WS_HN), (bf16_t*)(ws + WS_HP2), (float*)(ws + WS_SS2)};
        pg8::gemm_phase<EpiDown, pg8::StaticOrder>(lds, g, S, E);
    }
    SEAM(5);
    if (IN(6)) p6_final(a);
#undef IN
#undef SEAM
}

#ifndef ONE_LAUNCH
#define ONE_LAUNCH 1
#endif
#ifndef HOST_REP
#define HOST_REP -1
#endif
extern "C" void kernel_launch(void* const* d_in, const int* in_sizes, int n_in, void* d_out, int out_size, void* d_ws, size_t ws_size, hipStream_t stream) {
    static int grid = 0;
    if (grid == 0) {
        if (n_in != 18 || (size_t)out_size != OUT_TOTAL || ws_size < WS_END) { fprintf(stderr, "kernel_launch: unexpected shapes: n_in %d out %d ws %zu (need %zu)\n", n_in, out_size, ws_size, (size_t)WS_END); grid = -1; return; }
        int dev = 0, cus = 0, per_cu = 0;
        (void)hipGetDevice(&dev); (void)hipDeviceGetAttribute(&cus, hipDeviceAttributeMultiprocessorCount, dev);
        if (hipFuncSetAttribute((const void*)hymba_fwd, hipFuncAttributeMaxDynamicSharedMemorySize, LDS_BYTES) != hipSuccess) { fprintf(stderr, "kernel_launch: hipFuncSetAttribute failed\n"); grid = -1; return; }
        if (hipOccupancyMaxActiveBlocksPerMultiprocessor(&per_cu, (const void*)hymba_fwd, NTHREADS, LDS_BYTES) != hipSuccess || per_cu < 1) { fprintf(stderr, "kernel_launch: occupancy query says %d blocks per CU\n", per_cu); grid = -1; return; }
        grid = cus;
    }
    if (grid < 0) return;
    Args a{};
    for (int i = 0; i < 18; ++i) a.in[i] = (const float*)d_in[i];
    a.out = (float*)d_out; a.ws = (unsigned char*)d_ws;
#if ONE_LAUNCH
    a.ph_lo = 0; a.ph_hi = 7;
    void* args[] = {&a};
    hipError_t e = hipLaunchCooperativeKernel((const void*)hymba_fwd, dim3(grid), dim3(NTHREADS), args, LDS_BYTES, stream);
    if (e != hipSuccess) fprintf(stderr, "cooperative launch failed: %s (grid %d)\n", hipGetErrorString(e), grid);
#else
    for (int ph = 0; ph < 7; ++ph) for (int rep = 0; rep < (ph == HOST_REP ? 2 : 1); ++rep) { a.ph_lo = ph; a.ph_hi = ph + 1; hipLaunchKernelGGL(hymba_fwd, dim3(grid), dim3(NTHREADS), LDS_BYTES, stream, a); }
#endif
}
```

```cpp
#include <hip/hip_runtime.h>
#include <hip/hip_cooperative_groups.h>
#include <cstdio>
namespace cg = cooperative_groups;

#define PG8_LAS __attribute__((address_space(3)))
typedef unsigned short bf16_t;
typedef short bf16x8 __attribute__((ext_vector_type(8)));
typedef float f32x4 __attribute__((ext_vector_type(4)));
typedef float f32x16 __attribute__((ext_vector_type(16)));
typedef unsigned u32x4 __attribute__((ext_vector_type(4)));
typedef unsigned u32x2 __attribute__((ext_vector_type(2)));

constexpr int D = 2048, SEQ = 4096, NB = 4, NS = 128, NMETA = 16;
constexpr int MP = NB * SEQ;
constexpr int ROW_S = MP;
constexpr int ROW_M = MP + NS;
constexpr int ROW_E = ROW_M + NMETA;
constexpr int MROWS = 16640;
constexpr int NREAL = ROW_M;
constexpr int CONVD = 1024, ATTD = 1024, KVD = 256, HD = 64;
constexpr int INC = 4608, FF = 5632, GU = 2 * FF;
constexpr int NTHREADS = 512;
constexpr int PAST = 16384;
constexpr float EPS = 1e-6f;
constexpr int ROPE_ROWS = SEQ + NMETA + 1;

constexpr size_t OFF_Y = 0;
constexpr size_t OFF_KP = (size_t)(MP + NS) * D;
constexpr size_t OFF_VP = OFF_KP + (size_t)NB * 128 * KVD;
constexpr size_t OFF_CP = OFF_VP + (size_t)NB * 128 * KVD;
constexpr size_t OFF_KS = OFF_CP + (size_t)NB * 2 * CONVD;
constexpr size_t OFF_VS = OFF_KS + (size_t)NS * 128 * KVD;
constexpr size_t OFF_CS = OFF_VS + (size_t)NS * 128 * KVD;
constexpr size_t OUT_TOTAL = OFF_CS + (size_t)NS * 2 * CONVD;

constexpr size_t WS_WIN = 0;
constexpr size_t WS_WOUT = WS_WIN + (size_t)INC * D * 2;
constexpr size_t WS_WGU = WS_WOUT + (size_t)D * D * 2;
constexpr size_t WS_WDN = WS_WGU + (size_t)GU * D * 2;
constexpr size_t WS_HN = WS_WDN + (size_t)D * FF * 2;
constexpr size_t WS_C = WS_HN + (size_t)MROWS * D * 2;
constexpr size_t WS_BG = WS_C;
constexpr size_t WS_U = WS_BG + (size_t)MROWS * CONVD * 2;
constexpr size_t WS_Q = WS_U + (size_t)MROWS * CONVD * 2;
constexpr size_t WS_K = WS_Q + (size_t)MROWS * ATTD * 2;
constexpr size_t WS_V = WS_K + (size_t)MROWS * KVD * 2;
constexpr size_t WS_M = WS_V + (size_t)MROWS * KVD * 2;
constexpr size_t WS_HF = WS_C;
constexpr size_t WS_CEND = WS_C + (size_t)MROWS * FF * 2;
static_assert(WS_M + (size_t)MROWS * D * 2 <= WS_CEND, "region C");
constexpr size_t WS_ROPE = WS_CEND;
constexpr size_t WS_SS1 = WS_ROPE + (size_t)ROPE_ROWS * 64 * 4;
constexpr size_t WS_SS2 = WS_SS1 + (size_t)MROWS * 32 * 4;
constexpr size_t WS_SSS1 = WS_SS2 + (size_t)MROWS * 32 * 4;
constexpr size_t WS_SSS2 = WS_SSS1 + (size_t)NS * 128 * 4;
constexpr size_t WS_HP2 = WS_SSS2 + (size_t)NS * 128 * 4;
constexpr size_t WS_END = WS_HP2 + (size_t)MROWS * D * 2;

__device__ __forceinline__ unsigned cvt_pk_bf16(float lo, float hi) { unsigned r; asm volatile("v_cvt_pk_bf16_f32 %0, %1, %2" : "=v"(r) : "v"(lo), "v"(hi)); return r; }
__device__ __forceinline__ float bf_lo(unsigned u) { return __uint_as_float(u << 16); }
__device__ __forceinline__ float bf_hi(unsigned u) { return __uint_as_float(u & 0xffff0000u); }
__device__ __forceinline__ float bf2f(bf16_t x) { return __uint_as_float((unsigned)x << 16); }
__device__ __forceinline__ float wave_sum(float v) {
#pragma unroll
    for (int o = 32; o >= 1; o >>= 1) v += __shfl_xor(v, o);
    return v;
}
__device__ __forceinline__ float wave_max(float v) {
#pragma unroll
    for (int o = 32; o >= 1; o >>= 1) v = fmaxf(v, __shfl_xor(v, o));
    return v;
}
__device__ __forceinline__ int tpos_of_row(int row) { return row < MP ? NMETA + (row & (SEQ - 1)) : (row < ROW_M ? (SEQ + NMETA) : (row < ROW_E ? row - ROW_M : 0)); }

namespace pg8 {
constexpr int BM = 256, BK = 64, HALF = 128, HTB = HALF * BK * 2  , STAGE_BYTES = 8 * HTB, NXCD = 8, WGM = 8;
__host__ __device__ __forceinline__ int lds_byte(int r, int c) { const int st = (r >> 4) * 2 + (c >> 5), rr = r & 15, cc = c & 31, ob = rr * 64 + cc * 2; return st * 1024 + (ob ^ (((ob >> 9) & 1) << 5)); }
__host__ __device__ __forceinline__ void stage_rc(int b, int& R, int& C) { const int st = b / 1024, sb = b % 1024, swz = sb ^ (((sb >> 9) & 1) << 5); R = (st >> 1) * 16 + swz / 64; C = (st & 1) * 32 + (swz % 64) / 2; }
__host__ __device__ __forceinline__ int perm32(int rho) { const int n = rho >> 4, i = rho & 15; return 8 * (i >> 2) + 4 * n + (i & 3); }

struct Unit { int pm, pn; };
struct Gemm { const bf16_t* A; const bf16_t* Bt; int M, N, K; };

struct StaticOrder {
    int nM, nN, nwg, G, c;
    __host__ __device__ void init(int M, int N, int G_, int c_) { nM = M / BM; nN = N / BM; nwg = nM * nN; G = G_; c = c_; }
    __host__ __device__ bool next(int i, Unit& u) const {
        const long L = (long)i * G + c; if (L >= nwg) return false;
        int wgid = (int)L; { const int q = nwg / NXCD, r = nwg % NXCD, xcd = wgid % NXCD, off = wgid / NXCD; wgid = (xcd < r ? xcd * (q + 1) : r * (q + 1) + (xcd - r) * q) + off; }
        const int nig = WGM * nN, gid = wgid / nig, fm = gid * WGM, gsz = (nM - fm) < WGM ? (nM - fm) : WGM;
        u.pm = fm + ((wgid % nig) % gsz); u.pn = (wgid % nig) / gsz; return true;
    }
    __device__ __forceinline__ void a_ready(const Unit&) const {}
    __device__ __forceinline__ void done(const Unit&) const {}
};

template <class Epi, class Sched>
__device__ __forceinline__ void gemm_phase(PG8_LAS unsigned char* lds, const Gemm g, const Sched& S, const Epi& E) {
    const int tid = threadIdx.x, wid = __builtin_amdgcn_readfirstlane(tid >> 6), lane = tid & 63, wr = wid >> 2, wc = wid & 3, fr = lane & 15, fq = lane >> 4;
    const int K = g.K, nt = K / BK;
    unsigned voffA[2], voffB[2];
#pragma unroll
    for (int i = 0; i < 2; ++i) { int R, C; stage_rc(tid * 16 + i * 8192, R, C); const int Rb = Epi::PERM ? ((R & ~31) + perm32(R & 31)) : R;
        voffA[i] = (unsigned)(R * K + C) * 2u; voffB[i] = (unsigned)(Rb * K + C) * 2u; }
    const size_t kstep = (size_t)(BK * 2);
    const size_t hstep = (size_t)HALF * K * 2;
    const size_t tstep = 2 * hstep;
    const unsigned ldsw = (unsigned)wid * 1024u;
    const int aoff = lds_byte(wr * 64 + fr, fq * 8), boff = lds_byte(wc * 32 + fr, fq * 8);
#define PG8_SA(b, h) (((b) * 2 + (h)) * HTB)
#define PG8_SB(b, h) ((4 + (b) * 2 + (h)) * HTB)
#define PG8_STAGE(bufoff, gbase, voff) do { _Pragma("unroll") for (int _i = 0; _i < 2; ++_i) \
        __builtin_amdgcn_global_load_lds((const unsigned*)((const char*)(gbase) + (voff)[_i]), (PG8_LAS unsigned*)(lds + (bufoff) + ldsw + _i * 8192), 16, 0, 0); } while (0)
#define PG8_LDA(dst, b, h) do { _Pragma("unroll") for (int m = 0; m < 4; ++m) _Pragma("unroll") for (int k = 0; k < 2; ++k) dst[m][k] = *(const PG8_LAS bf16x8*)(lds + PG8_SA(b, h) + aoff + m * 2048 + k * 1024); } while (0)
#define PG8_LDB(dst, b, h) do { _Pragma("unroll") for (int n = 0; n < 2; ++n) _Pragma("unroll") for (int k = 0; k < 2; ++k) dst[n][k] = *(const PG8_LAS bf16x8*)(lds + PG8_SB(b, h) + boff + n * 2048 + k * 1024); } while (0)
#define PG8_MMA(ai, bj, At, Bt) do { __builtin_amdgcn_s_setprio(1); _Pragma("unroll") for (int m = 0; m < 4; ++m) _Pragma("unroll") for (int n = 0; n < 2; ++n) _Pragma("unroll") for (int k = 0; k < 2; ++k) \
        acc[ai][bj][m][n] = __builtin_amdgcn_mfma_f32_16x16x32_bf16(Bt[n][k], At[m][k], acc[ai][bj][m][n], 0, 0, 0); __builtin_amdgcn_s_setprio(0); } while (0)
#define PG8_WAIT_V(n) asm volatile("s_waitcnt vmcnt(" #n ")" ::: "memory")
#define PG8_WAIT_L(n) asm volatile("s_waitcnt lgkmcnt(" #n ")" ::: "memory")
#define PG8_BAR __builtin_amdgcn_s_barrier()
#define PG8_SCHED __builtin_amdgcn_sched_barrier(0)
    Unit cur, nxt; int ui = 0;
    if (!S.next(0, cur)) return;
    f32x4 acc[2][2][4][2];
#pragma unroll
    for (int a = 0; a < 2; ++a)
#pragma unroll
        for (int b = 0; b < 2; ++b)
#pragma unroll
            for (int m = 0; m < 4; ++m)
#pragma unroll
                for (int n = 0; n < 2; ++n) acc[a][b][m][n] = (f32x4){0.f, 0.f, 0.f, 0.f};
    bf16x8 At[4][2], B0[2][2], B1[2][2];
    const char* cA = (const char*)g.A + (size_t)cur.pm * tstep; const char* cB = (const char*)g.Bt + (size_t)cur.pn * tstep;
    S.a_ready(cur);
    PG8_STAGE(PG8_SB(0, 0), cB, voffB); PG8_STAGE(PG8_SA(0, 0), cA, voffA); PG8_STAGE(PG8_SB(0, 1), cB + hstep, voffB); PG8_STAGE(PG8_SA(0, 1), cA + hstep, voffA);
    if (wr == 1) PG8_BAR;
    PG8_WAIT_V(4); PG8_BAR;
    PG8_STAGE(PG8_SB(1, 0), cB + kstep, voffB); PG8_STAGE(PG8_SA(1, 0), cA + kstep, voffA); PG8_STAGE(PG8_SB(1, 1), cB + hstep + kstep, voffB);
    PG8_WAIT_V(6); PG8_BAR;
    for (;;) {
        const bool has_next = S.next(ui + 1, nxt);
        const char* nA = has_next ? (const char*)g.A + (size_t)nxt.pm * tstep : cA; const char* nB = has_next ? (const char*)g.Bt + (size_t)nxt.pn * tstep : cB;
        for (int t = 0; t < nt; t += 2) {
            const bool last = (t == nt - 2);
            const char* a1 = cA + (size_t)(t + 1) * kstep;
            const char* a2 = last ? nA : cA + (size_t)(t + 2) * kstep; const char* b2 = last ? nB : cB + (size_t)(t + 2) * kstep;
            const char* a3 = a2 + kstep; const char* b3 = b2 + kstep;
            if (last && has_next) S.a_ready(nxt);
            PG8_LDB(B0, 0, 0); PG8_SCHED; PG8_LDA(At, 0, 0); PG8_STAGE(PG8_SA(1, 1), a1 + hstep, voffA);
            PG8_WAIT_L(8); PG8_BAR; PG8_WAIT_L(0); PG8_MMA(0, 0, At, B0); PG8_BAR; PG8_SCHED;
            PG8_LDB(B1, 0, 1); PG8_STAGE(PG8_SB(0, 0), b2, voffB);
            PG8_BAR; PG8_WAIT_L(0); PG8_MMA(0, 1, At, B1); PG8_BAR;
            PG8_LDA(At, 0, 1); PG8_STAGE(PG8_SA(0, 0), a2, voffA);
            PG8_BAR; PG8_WAIT_L(0); PG8_MMA(1, 0, At, B0); PG8_BAR; PG8_SCHED;
            PG8_STAGE(PG8_SB(0, 1), b2 + hstep, voffB);
            PG8_WAIT_V(6); PG8_BAR; PG8_MMA(1, 1, At, B1); PG8_BAR;
            PG8_LDB(B0, 1, 0); PG8_SCHED; PG8_LDA(At, 1, 0); PG8_STAGE(PG8_SA(0, 1), a2 + hstep, voffA);
            PG8_WAIT_L(8); PG8_BAR; PG8_WAIT_L(0); PG8_MMA(0, 0, At, B0); PG8_BAR; PG8_SCHED;
            PG8_LDB(B1, 1, 1); PG8_STAGE(PG8_SB(1, 0), b3, voffB);
            PG8_BAR; PG8_WAIT_L(0); PG8_MMA(0, 1, At, B1); PG8_BAR;
            PG8_LDA(At, 1, 1); PG8_STAGE(PG8_SA(1, 0), a3, voffA);
            PG8_BAR; PG8_WAIT_L(0); PG8_MMA(1, 0, At, B0); PG8_BAR; PG8_SCHED;
            PG8_STAGE(PG8_SB(1, 1), b3 + hstep, voffB);
            PG8_WAIT_V(6); PG8_BAR; PG8_MMA(1, 1, At, B1); PG8_BAR;
        }
        if constexpr (!Epi::AFTER_DRAIN) { E(acc, cur, wr, wc, fr, fq); S.done(cur); }
        if (!has_next) break;
#pragma unroll
        for (int a = 0; a < 2; ++a)
#pragma unroll
            for (int b = 0; b < 2; ++b)
#pragma unroll
                for (int m = 0; m < 4; ++m)
#pragma unroll
                    for (int n = 0; n < 2; ++n) acc[a][b][m][n] = (f32x4){0.f, 0.f, 0.f, 0.f};
        cur = nxt; cA = nA; cB = nB; ++ui;
    }
    PG8_WAIT_V(0);
    if (wr == 0) PG8_BAR;
    PG8_BAR;
    if constexpr (Epi::AFTER_DRAIN) { E.fused(acc, cur, wr, wc, fr, fq, lds, wid, lane); S.done(cur); }
#undef PG8_SA
#undef PG8_SB
#undef PG8_STAGE
#undef PG8_LDA
#undef PG8_LDB
#undef PG8_MMA
#undef PG8_WAIT_V
#undef PG8_WAIT_L
#undef PG8_BAR
#undef PG8_SCHED
}
}
using pg8::Unit; using pg8::BM; using pg8::HALF;

__device__ __forceinline__ u32x4 pack8(const f32x4 a, const f32x4 b) { u32x4 w; w.x = cvt_pk_bf16(a[0], a[1]); w.y = cvt_pk_bf16(a[2], a[3]); w.z = cvt_pk_bf16(b[0], b[1]); w.w = cvt_pk_bf16(b[2], b[3]); return w; }
__device__ __forceinline__ u32x2 pack4(const f32x4 a) { u32x2 w; w.x = cvt_pk_bf16(a[0], a[1]); w.y = cvt_pk_bf16(a[2], a[3]); return w; }

struct EpiIn {
    static constexpr bool PERM = true, AFTER_DRAIN = false;
    bf16_t *bg, *u, *q, *k, *v; const float* rope;
    __device__ __forceinline__ void operator()(const f32x4 (&acc)[2][2][4][2], const Unit& un, int wr, int wc, int fr, int fq) const {
        const int row0 = un.pm * BM + wr * 64 + fr, pn = un.pn;
        if (pn < 4 || pn == 17) {
            bf16_t* base = pn < 4 ? bg : v; const int ld = pn < 4 ? CONVD : KVD; const int col0 = (pn < 4 ? pn * 256 : 0) + wc * 32 + 8 * fq;
#pragma unroll
            for (int ai = 0; ai < 2; ++ai)
#pragma unroll
                for (int m = 0; m < 4; ++m) { bf16_t* rowp = base + (size_t)(row0 + ai * HALF + m * 16) * ld + col0;
#pragma unroll
                    for (int bj = 0; bj < 2; ++bj) *(u32x4*)(rowp + bj * HALF) = pack8(acc[ai][bj][m][0], acc[ai][bj][m][1]); }
        } else if (pn < 12) {
            const int col0 = (pn - 4) * 128 + wc * 32 + 8 * fq;
#pragma unroll
            for (int ai = 0; ai < 2; ++ai)
#pragma unroll
                for (int m = 0; m < 4; ++m) { bf16_t* rowp = u + (size_t)(row0 + ai * HALF + m * 16) * CONVD + col0;
                    *(u32x4*)rowp = pack8(acc[ai][0][m][0] * acc[ai][1][m][0], acc[ai][0][m][1] * acc[ai][1][m][1]); }
        } else {
            const bool isq = pn < 16; bf16_t* base = isq ? q : k; const int ld = isq ? ATTD : KVD; const int hc = (isq ? (pn - 12) * 4 : 0) + wc; const float sc = isq ? 0.125f : 1.0f;
#pragma unroll
            for (int ai = 0; ai < 2; ++ai)
#pragma unroll
                for (int m = 0; m < 4; ++m) { const int row = row0 + ai * HALF + m * 16; const float* rp = rope + (size_t)tpos_of_row(row) * 64 + 8 * fq;
                    const f32x4 c0 = *(const f32x4*)rp * sc, c1 = *(const f32x4*)(rp + 4) * sc, s0 = *(const f32x4*)(rp + 32) * sc, s1 = *(const f32x4*)(rp + 36) * sc;
                    const f32x4 x1a = acc[ai][0][m][0], x1b = acc[ai][0][m][1], x2a = acc[ai][1][m][0], x2b = acc[ai][1][m][1];
                    bf16_t* dst = base + (size_t)row * ld + hc * 64 + 8 * fq;
                    *(u32x4*)dst = pack8(x1a * c0 - x2a * s0, x1b * c1 - x2b * s1);
                    *(u32x4*)(dst + 32) = pack8(x2a * c0 + x1a * s0, x2b * c1 + x1b * s1); }
        }
    }
};
struct EpiOut {
    static constexpr bool PERM = false, AFTER_DRAIN = false;
    const float* xp; bf16_t* a2; float* ssp;
    __device__ __forceinline__ void operator()(const f32x4 (&acc)[2][2][4][2], const Unit& un, int wr, int wc, int fr, int fq) const {
        const int row0 = un.pm * BM + wr * 64 + fr, col0 = un.pn * BM + wc * 32 + 4 * fq;
#pragma unroll
        for (int ai = 0; ai < 2; ++ai) {
            f32x4 xv[4][2][2];
#pragma unroll
            for (int m = 0; m < 4; ++m) { const float* xr = xp + (size_t)(row0 + ai * HALF + m * 16) * D + col0;
#pragma unroll
                for (int bj = 0; bj < 2; ++bj)
#pragma unroll
                    for (int n = 0; n < 2; ++n) xv[m][bj][n] = *(const f32x4*)(xr + bj * HALF + n * 16); }
#pragma unroll
            for (int m = 0; m < 4; ++m) { const int row = row0 + ai * HALF + m * 16;
                bf16_t* ar = a2 + (size_t)row * D + col0; float ss = 0.f;
#pragma unroll
                for (int bj = 0; bj < 2; ++bj)
#pragma unroll
                    for (int n = 0; n < 2; ++n) { const f32x4 h = xv[m][bj][n] + acc[ai][bj][m][n];
                        *(u32x2*)(ar + bj * HALF + n * 16) = pack4(h);
                        ss += (h[0] * h[0] + h[1] * h[1]) + (h[2] * h[2] + h[3] * h[3]); }
                ss += __shfl_xor(ss, 16); ss += __shfl_xor(ss, 32);
                if (fq == 0) ssp[(size_t)row * 32 + un.pn * 4 + wc] = ss; }
        }
    }
};
struct EpiGU {
    static constexpr bool PERM = true, AFTER_DRAIN = false;
    const float* ssp; bf16_t* hf;
    __device__ __forceinline__ void operator()(const f32x4 (&acc)[2][2][4][2], const Unit& un, int wr, int wc, int fr, int fq) const {
        const int row0 = un.pm * BM + wr * 64 + fr, col0 = un.pn * 128 + wc * 32 + 8 * fq;
        float rs[2][4];
        { f32x4 pa[2][4], pb[2][4];
#pragma unroll
          for (int ai = 0; ai < 2; ++ai)
#pragma unroll
              for (int m = 0; m < 4; ++m) { const float* sp = ssp + (size_t)(row0 + ai * HALF + m * 16) * 32 + fq * 8; pa[ai][m] = *(const f32x4*)sp; pb[ai][m] = *(const f32x4*)(sp + 4); }
#pragma unroll
          for (int ai = 0; ai < 2; ++ai)
#pragma unroll
              for (int m = 0; m < 4; ++m) { float t = ((pa[ai][m][0] + pa[ai][m][1]) + (pa[ai][m][2] + pa[ai][m][3])) + ((pb[ai][m][0] + pb[ai][m][1]) + (pb[ai][m][2] + pb[ai][m][3]));
                  t += __shfl_xor(t, 16); t += __shfl_xor(t, 32); rs[ai][m] = rsqrtf(t * (1.0f / D) + EPS); } }
#pragma unroll
        for (int ai = 0; ai < 2; ++ai) {
#pragma unroll
            for (int m = 0; m < 4; ++m) { const int row = row0 + ai * HALF + m * 16; const float rstd = rs[ai][m];
                f32x4 h[2];
#pragma unroll
                for (int n = 0; n < 2; ++n) { const f32x4 g = acc[ai][0][m][n] * rstd, uu = acc[ai][1][m][n] * rstd;
#pragma unroll
                    for (int j = 0; j < 4; ++j) h[n][j] = g[j] * uu[j] * __builtin_amdgcn_rcpf(1.0f + __expf(-g[j])); }
                *(u32x4*)(hf + (size_t)row * FF + col0) = pack8(h[0], h[1]); }
        }
    }
};
struct EpiDown {
    static constexpr bool PERM = false, AFTER_DRAIN = false;
    const bf16_t* a2; bf16_t* hp2; float* ssp;
    __device__ __forceinline__ void operator()(const f32x4 (&acc)[2][2][4][2], const Unit& un, int wr, int wc, int fr, int fq) const {
        const int row0 = un.pm * BM + wr * 64 + fr, col0 = un.pn * BM + wc * 32 + 4 * fq;
        u32x2 rv[2][4][2][2];
#pragma unroll
        for (int ai = 0; ai < 2; ++ai)
#pragma unroll
            for (int m = 0; m < 4; ++m) { const bf16_t* ar = a2 + (size_t)(row0 + ai * HALF + m * 16) * D + col0;
#pragma unroll
                for (int bj = 0; bj < 2; ++bj)
#pragma unroll
                    for (int n = 0; n < 2; ++n) rv[ai][m][bj][n] = *(const u32x2*)(ar + bj * HALF + n * 16); }
#pragma unroll
        for (int ai = 0; ai < 2; ++ai) {
#pragma unroll
            for (int m = 0; m < 4; ++m) { const int row = row0 + ai * HALF + m * 16;
                bf16_t* hr = hp2 + (size_t)row * D + col0; float ss = 0.f;
#pragma unroll
                for (int bj = 0; bj < 2; ++bj)
#pragma unroll
                    for (int n = 0; n < 2; ++n) { const u32x2 w = rv[ai][m][bj][n];
                        const f32x4 h = (f32x4){bf_lo(w.x), bf_hi(w.x), bf_lo(w.y), bf_hi(w.y)} + acc[ai][bj][m][n];
                        *(u32x2*)(hr + bj * HALF + n * 16) = pack4(h);
                        ss += (h[0] * h[0] + h[1] * h[1]) + (h[2] * h[2] + h[3] * h[3]); }
                ss += __shfl_xor(ss, 16); ss += __shfl_xor(ss, 32);
                if (fq == 0) ssp[(size_t)row * 32 + un.pn * 4 + wc] = ss; }
        }
    }
};

#define MFMA16(a, b, c) __builtin_amdgcn_mfma_f32_16x16x32_bf16((a), (b), (c), 0, 0, 0)
template <int NG, class Epi>
__device__ __forceinline__ void skinny_gemm(const bf16_t* A, const bf16_t* Bt, const int K, const int nitems, const Epi& E, PG8_LAS unsigned char* lds) {
    const int tid = threadIdx.x, lane = tid & 63, wid = tid >> 6, fr = lane & 15, fq = lane >> 4;
    const int kw = K >> 3; const bf16_t* ap = A + (size_t)fr * K + wid * kw + fq * 8;
    PG8_LAS f32x4* red = (PG8_LAS f32x4*)lds;
    for (int item = blockIdx.x; item < nitems; item += gridDim.x) {
        const bf16_t* bp[NG]; f32x4 acc[NG][8];
#pragma unroll
        for (int g = 0; g < NG; ++g) { bp[g] = Bt + (size_t)(E.brow(item, g) + fr) * K + wid * kw + fq * 8;
#pragma unroll
            for (int rg = 0; rg < 8; ++rg) acc[g][rg] = (f32x4){0.f, 0.f, 0.f, 0.f}; }
        constexpr int SB = 2;
#pragma unroll 1
        for (int k0 = 0; k0 < kw; k0 += 32 * SB) {
            bf16x8 bv[SB][NG], av[SB][8];
#pragma unroll
            for (int st = 0; st < SB; ++st) {
#pragma unroll
                for (int g = 0; g < NG; ++g) bv[st][g] = *(const bf16x8*)(bp[g] + k0 + st * 32);
#pragma unroll
                for (int rg = 0; rg < 8; ++rg) av[st][rg] = *(const bf16x8*)(ap + (size_t)(rg * 16) * K + k0 + st * 32);
            }
#pragma unroll
            for (int st = 0; st < SB; ++st)
#pragma unroll
                for (int g = 0; g < NG; ++g)
#pragma unroll
                    for (int rg = 0; rg < 8; ++rg) acc[g][rg] = MFMA16(bv[st][g], av[st][rg], acc[g][rg]);
        }
#pragma unroll
        for (int g = 0; g < NG; ++g)
#pragma unroll
            for (int rg = 0; rg < 8; ++rg) red[((wid * NG + g) * 8 + rg) * 64 + lane] = acc[g][rg];
        __syncthreads();
        f32x4 fin[NG];
#pragma unroll
        for (int g = 0; g < NG; ++g) { fin[g] = red[((0 * NG + g) * 8 + wid) * 64 + lane];
#pragma unroll
            for (int w2 = 1; w2 < 8; ++w2) fin[g] += red[((w2 * NG + g) * 8 + wid) * 64 + lane]; }
        E(fin, item, wid * 16 + fr, fq);
        __syncthreads();
    }
}
struct SkOut {
    const float* xs; bf16_t* a2; float* ssS;
    __device__ __forceinline__ int brow(int item, int) const { return item * 16; }
    __device__ __forceinline__ void operator()(const f32x4 (&acc)[1], int item, int r, int fq) const {
        const int c = item * 16 + 4 * fq; const f32x4 h = *(const f32x4*)(xs + (size_t)r * D + c) + acc[0];
        *(u32x2*)(a2 + (size_t)(ROW_S + r) * D + c) = pack4(h);
        float ss = (h[0] * h[0] + h[1] * h[1]) + (h[2] * h[2] + h[3] * h[3]); ss += __shfl_xor(ss, 16); ss += __shfl_xor(ss, 32);
        if (fq == 0) ssS[r * 128 + item] = ss;
    }
};
struct SkGU {
    bf16_t* hf; float rstd;
    __device__ __forceinline__ int brow(int item, int g) const { return (item >> 3) * 256 + (item & 7) * 16 + g * 128; }
    __device__ __forceinline__ void operator()(const f32x4 (&acc)[2], int item, int r, int fq) const {
        const f32x4 g = acc[0] * rstd, uu = acc[1] * rstd; f32x4 h;
#pragma unroll
        for (int j = 0; j < 4; ++j) h[j] = g[j] * uu[j] * __builtin_amdgcn_rcpf(1.0f + __expf(-g[j]));
        *(u32x2*)(hf + (size_t)(ROW_S + r) * FF + item * 16 + 4 * fq) = pack4(h);
    }
};
struct SkDown {
    const bf16_t* a2; bf16_t* hp2; float* ssS;
    __device__ __forceinline__ int brow(int item, int) const { return item * 16; }
    __device__ __forceinline__ void operator()(const f32x4 (&acc)[1], int item, int r, int fq) const {
        const int c = item * 16 + 4 * fq; const u32x2 w = *(const u32x2*)(a2 + (size_t)(ROW_S + r) * D + c);
        const f32x4 h = (f32x4){bf_lo(w.x), bf_hi(w.x), bf_lo(w.y), bf_hi(w.y)} + acc[0];
        *(u32x2*)(hp2 + (size_t)(ROW_S + r) * D + c) = pack4(h);
        float ss = (h[0] * h[0] + h[1] * h[1]) + (h[2] * h[2] + h[3] * h[3]); ss += __shfl_xor(ss, 16); ss += __shfl_xor(ss, 32);
        if (fq == 0) ssS[r * 128 + item] = ss;
    }
};

struct EpiNull {
    static constexpr bool PERM = true, AFTER_DRAIN = false;
    __device__ __forceinline__ void operator()(const f32x4 (&acc)[2][2][4][2], const Unit&, int, int, int, int) const {
#pragma unroll
        for (int ai = 0; ai < 2; ++ai)
#pragma unroll
            for (int bj = 0; bj < 2; ++bj)
#pragma unroll
                for (int m = 0; m < 4; ++m)
#pragma unroll
                    for (int n = 0; n < 2; ++n) asm volatile("" :: "v"(acc[ai][bj][m][n]));
    }
};

struct Args { const float* in[18]; float* out; unsigned char* ws; int ph_lo, ph_hi; };
enum { I_XP = 0, I_XS, I_CK, I_CV, I_ST, I_META, I_G1, I_WIN, I_CW, I_CG, I_AG, I_SINK, I_WOUT, I_G2, I_WG, I_WU, I_WD, I_GF };

constexpr int XP_PITCH = 260;
__device__ __forceinline__ const float* xp_src(const int mode, const int G, const float* s0, const float* s1) {
    const int pn = G >> 3, g8 = G & 7, bj = g8 >> 2, hh = g8 & 3; int sc; const float* src = s0;
    if (mode == 0) {
        if (pn < 4) sc = G * 32;
        else if (pn < 12) sc = (bj ? 2048 : 1024) + (pn - 4) * 128 + hh * 32;
        else if (pn < 16) sc = 3072 + ((pn - 12) * 4 + hh) * 64 + bj * 32;
        else if (pn == 16) sc = 4096 + hh * 64 + bj * 32;
        else sc = 4352 + g8 * 32;
    } else if (mode == 1) { sc = G * 32; }
    else { src = bj ? s1 : s0; sc = pn * 128 + hh * 32; }
    return src + sc;
}
__device__ __forceinline__ void xpose_weight(const int mode, const float* s0, const float* s1, const int Nsrc, const int K, bf16_t* dst, const int Ndst, const float* kscale, const int bfirst, const int bstep, PG8_LAS unsigned char* lds) {
    const int tid = threadIdx.x, wid = tid >> 6, c4 = tid & 63;
    PG8_LAS float* tile = (PG8_LAS float*)lds;
    const int nT = Ndst / 256, nkc = K / 64; const int nitems = nT * nkc;
    f32x4 rg[8];
    int item = bfirst;
    if (item < nitems) { const int kc = item / nT, T = item % nT; const float* sp = xp_src(mode, T * 8 + (c4 >> 3), s0, s1) + (size_t)(kc * 64 + wid) * Nsrc + (c4 & 7) * 4;
#pragma unroll
        for (int i = 0; i < 8; ++i) rg[i] = *(const f32x4*)(sp + (size_t)(8 * i) * Nsrc); }
    for (; item < nitems; item += bstep) {
        const int kc = item / nT, T = item % nT;
#pragma unroll
        for (int i = 0; i < 8; ++i) { const int k = wid + 8 * i; f32x4 v = rg[i]; if (kscale) v *= kscale[kc * 64 + k];
            *(PG8_LAS f32x4*)(tile + k * XP_PITCH + ((c4 * 4) ^ (((k >> 3) & 7) << 3))) = v; }
        __syncthreads();
        { const int nx = item + bstep;
          if (nx < nitems) { const int kc2 = nx / nT, T2 = nx % nT; const float* sp = xp_src(mode, T2 * 8 + (c4 >> 3), s0, s1) + (size_t)(kc2 * 64 + wid) * Nsrc + (c4 & 7) * 4;
#pragma unroll
            for (int i = 0; i < 8; ++i) rg[i] = *(const f32x4*)(sp + (size_t)(8 * i) * Nsrc); } }
        const int kg = tid & 7;
#pragma unroll
        for (int j = 0; j < 4; ++j) { const int n = (tid >> 3) + 64 * j; const PG8_LAS float* tp = tile + (8 * kg) * XP_PITCH + (n ^ (kg << 3));
            u32x4 w; w.x = cvt_pk_bf16(tp[0], tp[XP_PITCH]); w.y = cvt_pk_bf16(tp[2 * XP_PITCH], tp[3 * XP_PITCH]); w.z = cvt_pk_bf16(tp[4 * XP_PITCH], tp[5 * XP_PITCH]); w.w = cvt_pk_bf16(tp[6 * XP_PITCH], tp[7 * XP_PITCH]);
            *(u32x4*)(dst + (size_t)(T * 256 + n) * K + kc * 64 + 8 * kg) = w; }
        __syncthreads();
    }
}
constexpr int P1_UNITS = (MROWS / 256) * (INC / 256);
__device__ __forceinline__ void p1_slack_convert(const Args& a, PG8_LAS unsigned char* lds) {
    int nfull = P1_UNITS - 4 * (int)gridDim.x;
    if ((int)gridDim.x != 256 || nfull < 0 || nfull >= 256) nfull = 0;
    if ((int)blockIdx.x < nfull) return;
    const int bf = (int)blockIdx.x - nfull, bs = (int)gridDim.x - nfull;
    xpose_weight(1, a.in[I_WOUT], nullptr, D, D, (bf16_t*)(a.ws + WS_WOUT), D, nullptr, bf, bs, lds);
    xpose_weight(1, a.in[I_WD], nullptr, D, FF, (bf16_t*)(a.ws + WS_WDN), D, nullptr, bf, bs, lds);
}

__device__ __forceinline__ void p0_prep(const Args& a, PG8_LAS unsigned char* lds) {
    const int tid = threadIdx.x, lane = tid & 63, wid = tid >> 6;
    unsigned char* ws = a.ws;
    {
        bf16_t* hn = (bf16_t*)(ws + WS_HN); const float* g1 = a.in[I_G1];
        for (int row = blockIdx.x * 8 + wid; row < MROWS; row += gridDim.x * 8) {
            bf16_t* dst = hn + (size_t)row * D;
            if (row >= ROW_E) {
#pragma unroll
                for (int i = 0; i < 8; ++i) *(u32x2*)(dst + (i * 64 + lane) * 4) = (u32x2){0u, 0u};
                continue;
            }
            const float* src = row < MP ? a.in[I_XP] + (size_t)row * D : (row < ROW_M ? a.in[I_XS] + (size_t)(row - MP) * D : a.in[I_META] + (size_t)(row - ROW_M) * D);
            f32x4 v[8]; float ss = 0.f;
#pragma unroll
            for (int i = 0; i < 8; ++i) { v[i] = *(const f32x4*)(src + (i * 64 + lane) * 4); ss += (v[i][0] * v[i][0] + v[i][1] * v[i][1]) + (v[i][2] * v[i][2] + v[i][3] * v[i][3]); }
            ss = wave_sum(ss); const float rstd = rsqrtf(ss * (1.0f / D) + EPS);
#pragma unroll
            for (int i = 0; i < 8; ++i) { const f32x4 g = *(const f32x4*)(g1 + (i * 64 + lane) * 4); *(u32x2*)(dst + (i * 64 + lane) * 4) = pack4(v[i] * rstd * g); }
        }
    }
    xpose_weight(0, a.in[I_WIN], nullptr, INC, D, (bf16_t*)(ws + WS_WIN), INC, nullptr, blockIdx.x, gridDim.x, lds);
    xpose_weight(2, a.in[I_WG], a.in[I_WU], FF, D, (bf16_t*)(ws + WS_WGU), GU, a.in[I_G2], blockIdx.x, gridDim.x, lds);
    {
        float* rope = (float*)(ws + WS_ROPE);
        for (int idx = blockIdx.x * NTHREADS + tid; idx < ROPE_ROWS * 32; idx += gridDim.x * NTHREADS) {
            const int tp = idx >> 5, i = idx & 31; const double pos = tp < SEQ + NMETA ? (double)tp : (double)PAST;
            double inv = 1.0; for (int j = 0; j < i; ++j) inv *= 0.7498942093324559;
            double t = pos * inv * 0.15915494309189535; t -= floor(t + 0.5); const double r = t * 6.283185307179586, r2 = r * r;
            double sn = r, cs = 1.0, ts = r, tc = 1.0;
            for (int kq = 1; kq <= 15; ++kq) { tc *= -r2 / (double)((2 * kq - 1) * (2 * kq)); cs += tc; ts *= -r2 / (double)((2 * kq) * (2 * kq + 1)); sn += ts; }
            rope[tp * 64 + i] = (float)cs; rope[tp * 64 + 32 + i] = (float)sn;
        }
    }
    {
        const f32x4* ck = (const f32x4*)a.in[I_CK]; const f32x4* cv = (const f32x4*)a.in[I_CV]; const f32x4* st = (const f32x4*)a.in[I_ST];
        f32x4* oks = (f32x4*)(a.out + OFF_KS); f32x4* ovs = (f32x4*)(a.out + OFF_VS); f32x4* ocs = (f32x4*)(a.out + OFF_CS);
        for (int idx = blockIdx.x * NTHREADS + tid; idx < NS * 127 * 64; idx += gridDim.x * NTHREADS) {
            const int s = idx / (127 * 64), rem = idx - s * (127 * 64);
            oks[(size_t)s * 128 * 64 + rem] = ck[(size_t)s * 128 * 64 + 64 + rem]; ovs[(size_t)s * 128 * 64 + rem] = cv[(size_t)s * 128 * 64 + 64 + rem];
        }
        for (int idx = blockIdx.x * NTHREADS + tid; idx < NS * 256; idx += gridDim.x * NTHREADS) { const int s = idx >> 8, c = idx & 255; ocs[(s * 2) * 256 + c] = st[(s * 2 + 1) * 256 + c]; }
    }
}

#define MFMA32(a, b, c) __builtin_amdgcn_mfma_f32_32x32x16_bf16((a), (b), (c), 0, 0, 0)
constexpr int KS_P = 72, VT_P = 200;
constexpr int L_KS = 0, L_VT = 192 * KS_P * 2, L_SSQ = L_VT + 64 * VT_P * 2, L_SQ = L_SSQ + 64 * 16 * 4, L_SP = L_SQ + 1024 * 4, L_P2END = L_SP + 8 * 2 * 128 * 4;
static_assert(L_P2END <= pg8::STAGE_BYTES, "P2 LDS");

struct ConvCoef { f32x4 w0[4], w1[4], w2[4], g[4]; };
__device__ __forceinline__ void unpack8(const u32x4 p, f32x4& a, f32x4& b) { a = (f32x4){bf_lo(p.x), bf_hi(p.x), bf_lo(p.y), bf_hi(p.y)}; b = (f32x4){bf_lo(p.z), bf_hi(p.z), bf_lo(p.w), bf_hi(p.w)}; }

__device__ __forceinline__ void p2_prompt_item(const Args& a, PG8_LAS unsigned char* lds, const int item) {
    const int tid = threadIdx.x, lane = tid & 63, wid = __builtin_amdgcn_readfirstlane(tid >> 6);
    unsigned char* ws = a.ws;
    const bf16_t* bgp = (const bf16_t*)(ws + WS_BG); const bf16_t* up = (const bf16_t*)(ws + WS_U); const bf16_t* qp = (const bf16_t*)(ws + WS_Q);
    const bf16_t* kp = (const bf16_t*)(ws + WS_K); const bf16_t* vp = (const bf16_t*)(ws + WS_V); bf16_t* mm = (bf16_t*)(ws + WS_M);
    PG8_LAS bf16_t* Ks = (PG8_LAS bf16_t*)(lds + L_KS); PG8_LAS bf16_t* Vt = (PG8_LAS bf16_t*)(lds + L_VT); PG8_LAS float* ssq = (PG8_LAS float*)(lds + L_SSQ);
    const int b = item >> 6, t0 = (item & 63) * 64;
    {
        ConvCoef cf; const float* cw = a.in[I_CW]; const float* cg = a.in[I_CG];
#pragma unroll
        for (int i = 0; i < 2; ++i) { const int c = i * 512 + lane * 8;
#pragma unroll
            for (int h = 0; h < 2; ++h) { cf.w0[i * 2 + h] = *(const f32x4*)(cw + c + 4 * h); cf.w1[i * 2 + h] = *(const f32x4*)(cw + CONVD + c + 4 * h); cf.w2[i * 2 + h] = *(const f32x4*)(cw + 2 * CONVD + c + 4 * h); cf.g[i * 2 + h] = *(const f32x4*)(cg + c + 4 * h); } }
        for (int tt = 0; tt < 8; tt += 2) {
            u32x4 ru0[2][2], ru1[2][2], ru2[2][2], rb[2][2];
#pragma unroll
            for (int q2 = 0; q2 < 2; ++q2) { const int t = t0 + wid * 8 + tt + q2, row = b * SEQ + t;
                const int r1 = t >= 1 ? row - 1 : ROW_M + 15, r2 = t >= 2 ? row - 2 : (t == 1 ? ROW_M + 15 : ROW_M + 14);
#pragma unroll
                for (int i = 0; i < 2; ++i) { const int c = i * 512 + lane * 8;
                    ru0[q2][i] = *(const u32x4*)(up + (size_t)row * CONVD + c); ru1[q2][i] = *(const u32x4*)(up + (size_t)r1 * CONVD + c);
                    ru2[q2][i] = *(const u32x4*)(up + (size_t)r2 * CONVD + c); rb[q2][i] = *(const u32x4*)(bgp + (size_t)row * CONVD + c); } }
#pragma unroll
            for (int q2 = 0; q2 < 2; ++q2) { const int t = t0 + wid * 8 + tt + q2, row = b * SEQ + t;
                f32x4 x[4]; float ss = 0.f;
#pragma unroll
                for (int i = 0; i < 2; ++i) { const int c = i * 512 + lane * 8;
                    f32x4 u0a, u0b, u1a, u1b, u2a, u2b, ba, bb;
                    unpack8(ru0[q2][i], u0a, u0b); unpack8(ru1[q2][i], u1a, u1b); unpack8(ru2[q2][i], u2a, u2b); unpack8(rb[q2][i], ba, bb);
                    x[i * 2] = ba * (cf.w0[i * 2] * u2a + cf.w1[i * 2] * u1a + cf.w2[i * 2] * u0a); x[i * 2 + 1] = bb * (cf.w0[i * 2 + 1] * u2b + cf.w1[i * 2 + 1] * u1b + cf.w2[i * 2 + 1] * u0b);
                    if (t >= SEQ - 2) { float* o = a.out + OFF_CP + (size_t)(b * 2 + (t - (SEQ - 2))) * CONVD + c; *(f32x4*)o = u0a; *(f32x4*)(o + 4) = u0b; }
                }
#pragma unroll
                for (int e = 0; e < 4; ++e) ss += (x[e][0] * x[e][0] + x[e][1] * x[e][1]) + (x[e][2] * x[e][2] + x[e][3] * x[e][3]);
                ss = wave_sum(ss); const float rstd = rsqrtf(ss * (1.0f / CONVD) + EPS);
#pragma unroll
                for (int i = 0; i < 2; ++i) *(u32x4*)(mm + (size_t)row * D + i * 512 + lane * 8) = pack8(x[i * 2] * rstd * cf.g[i * 2], x[i * 2 + 1] * rstd * cf.g[i * 2 + 1]);
            }
        }
    }
    if (t0 >= SEQ - 128) {
#pragma unroll
        for (int i = 0; i < 4; ++i) { const int idx = tid + i * NTHREADS, tl = idx >> 5, c8 = idx & 31; const int row = b * SEQ + t0 + tl; const size_t o = (size_t)(b * 128 + (t0 + tl - (SEQ - 128))) * KVD + c8 * 8;
            f32x4 x0, x1; unpack8(*(const u32x4*)(kp + (size_t)row * KVD + c8 * 8), x0, x1); *(f32x4*)(a.out + OFF_KP + o) = x0; *(f32x4*)(a.out + OFF_KP + o + 4) = x1;
            unpack8(*(const u32x4*)(vp + (size_t)row * KVD + c8 * 8), x0, x1); *(f32x4*)(a.out + OFF_VP + o) = x0; *(f32x4*)(a.out + OFF_VP + o + 4) = x1; }
    }
    const int P0 = NMETA + t0, c32 = lane & 31, g = lane >> 5, hq = wid & 1, qi = hq * 32 + c32, rowq = b * SEQ + t0 + qi, jmin = 128 - P0;
    const float* sinks = a.in[I_SINK];
    u32x4 pk[3], pv[3];
#define P2_LOAD_KV(KH) do { _Pragma("unroll") for (int i = 0; i < 3; ++i) { const int idx = tid + i * NTHREADS, j = idx >> 3, c = idx & 7; const int pos = P0 - 128 + j; \
        pk[i] = (u32x4){0u, 0u, 0u, 0u}; pv[i] = (u32x4){0u, 0u, 0u, 0u}; \
        if (pos >= 0) { const int rk = pos < NMETA ? ROW_M + pos : b * SEQ + pos - NMETA; pk[i] = *(const u32x4*)(kp + (size_t)rk * KVD + (KH) * 64 + c * 8); pv[i] = *(const u32x4*)(vp + (size_t)rk * KVD + (KH) * 64 + c * 8); } } \
        } while (0)
    P2_LOAD_KV(0);
    for (int kh = 0; kh < 4; ++kh) {
        bf16x8 Qf[4];
#pragma unroll
        for (int kk = 0; kk < 4; ++kk) Qf[kk] = *(const bf16x8*)(qp + (size_t)rowq * ATTD + (kh * 4 + (wid >> 1)) * 64 + g * 8 + kk * 16);
        __syncthreads();
#pragma unroll
        for (int i = 0; i < 3; ++i) {
            const int idx = tid + i * NTHREADS, j = idx >> 3, c = idx & 7; const u32x4 kv = pk[i], vv = pv[i];
            *(PG8_LAS u32x4*)(Ks + j * KS_P + c * 8) = kv;
            PG8_LAS bf16_t* vt = Vt + (c * 8) * VT_P + j;
            vt[0] = (bf16_t)(vv.x & 0xffffu); vt[VT_P] = (bf16_t)(vv.x >> 16); vt[2 * VT_P] = (bf16_t)(vv.y & 0xffffu); vt[3 * VT_P] = (bf16_t)(vv.y >> 16);
            vt[4 * VT_P] = (bf16_t)(vv.z & 0xffffu); vt[5 * VT_P] = (bf16_t)(vv.z >> 16); vt[6 * VT_P] = (bf16_t)(vv.w & 0xffffu); vt[7 * VT_P] = (bf16_t)(vv.w >> 16);
        }
        __syncthreads();
        if (kh < 3) P2_LOAD_KV(kh + 1);
        const int qh = kh * 4 + (wid >> 1);
        f32x16 S[5];
#pragma unroll
        for (int T = 0; T < 5; ++T) {
#pragma unroll
            for (int e = 0; e < 16; ++e) S[T][e] = 0.f;
            const int key = (hq + T) * 32 + c32;
#pragma unroll
            for (int kk = 0; kk < 4; ++kk) { const bf16x8 Kf = *(const PG8_LAS bf16x8*)(Ks + key * KS_P + g * 8 + kk * 16); S[T] = MFMA32(Kf, Qf[kk], S[T]); }
        }
        const float sink = sinks[qh];
        float mx = sink;
#pragma unroll
        for (int T = 0; T < 5; ++T)
#pragma unroll
            for (int e = 0; e < 16; ++e) { const int r = (e & 3) + 8 * (e >> 2) + 4 * g; const int j = (hq + T) * 32 + r;
                bool ok = j >= jmin; if (T == 0) ok = ok && (r >= c32); if (T == 4) ok = ok && (r <= c32);
                const float sv = ok ? S[T][e] : -1e30f; S[T][e] = sv; mx = fmaxf(mx, sv); }
        mx = fmaxf(mx, __shfl_xor(mx, 32));
        float sum = 0.f;
#pragma unroll
        for (int T = 0; T < 5; ++T)
#pragma unroll
            for (int e = 0; e < 16; ++e) { const float p = __expf(S[T][e] - mx); S[T][e] = p; sum += p; }
        sum += __shfl_xor(sum, 32);
        const float inv = 1.0f / (sum + __expf(sink - mx));
        f32x16 O[2];
#pragma unroll
        for (int e = 0; e < 16; ++e) { O[0][e] = 0.f; O[1][e] = 0.f; }
#pragma unroll
        for (int T = 0; T < 5; ++T)
#pragma unroll
            for (int ch = 0; ch < 2; ++ch) {
                u32x4 pw; pw.x = cvt_pk_bf16(S[T][8 * ch + 0], S[T][8 * ch + 1]); pw.y = cvt_pk_bf16(S[T][8 * ch + 2], S[T][8 * ch + 3]); pw.z = cvt_pk_bf16(S[T][8 * ch + 4], S[T][8 * ch + 5]); pw.w = cvt_pk_bf16(S[T][8 * ch + 6], S[T][8 * ch + 7]);
                const bf16x8 Pf = __builtin_bit_cast(bf16x8, pw);
                const int keyb = (hq + T) * 32 + ch * 16 + 4 * g;
#pragma unroll
                for (int dt = 0; dt < 2; ++dt) { const int d = dt * 32 + c32;
                    const u32x2 lo = *(const PG8_LAS u32x2*)(Vt + d * VT_P + keyb), hi = *(const PG8_LAS u32x2*)(Vt + d * VT_P + keyb + 8);
                    const u32x4 vw = {lo.x, lo.y, hi.x, hi.y};
                    O[dt] = MFMA32(__builtin_bit_cast(bf16x8, vw), Pf, O[dt]); }
            }
        float ssl = 0.f;
#pragma unroll
        for (int dt = 0; dt < 2; ++dt)
#pragma unroll
            for (int i4 = 0; i4 < 4; ++i4) { const int d = dt * 32 + 8 * i4 + 4 * g;
                const f32x4 o = (f32x4){O[dt][4 * i4], O[dt][4 * i4 + 1], O[dt][4 * i4 + 2], O[dt][4 * i4 + 3]} * inv;
                *(u32x2*)(mm + (size_t)rowq * D + CONVD + qh * 64 + d) = pack4(o);
                ssl += (o[0] * o[0] + o[1] * o[1]) + (o[2] * o[2] + o[3] * o[3]); }
        ssl += __shfl_xor(ssl, 32);
        if (g == 0) ssq[qi * 16 + qh] = ssl;
    }
    __syncthreads();
    {
        float tot = 0.f;
#pragma unroll
        for (int h4 = 0; h4 < 4; ++h4) { const f32x4 sv = *(const PG8_LAS f32x4*)(ssq + qi * 16 + h4 * 4); tot += (sv[0] + sv[1]) + (sv[2] + sv[3]); }
        const float rstd = rsqrtf(tot * (1.0f / ATTD) + EPS); const float* ag = a.in[I_AG];
        for (int kh = 0; kh < 4; ++kh) { const int qh = kh * 4 + (wid >> 1);
#pragma unroll
            for (int dt = 0; dt < 2; ++dt)
#pragma unroll
                for (int i4 = 0; i4 < 4; ++i4) { const int d = dt * 32 + 8 * i4 + 4 * g; bf16_t* p = mm + (size_t)rowq * D + CONVD + qh * 64 + d;
                    const u32x2 w = *(const u32x2*)p; const f32x4 gv = *(const f32x4*)(ag + qh * 64 + d);
                    const f32x4 o = (f32x4){bf_lo(w.x), bf_hi(w.x), bf_lo(w.y), bf_hi(w.y)} * rstd * gv; *(u32x2*)p = pack4(o); } }
    }
    __syncthreads();
}

__device__ __forceinline__ void p2_sample_item(const Args& a, PG8_LAS unsigned char* lds, const int s) {
    const int tid = threadIdx.x, lane = tid & 63, wid = __builtin_amdgcn_readfirstlane(tid >> 6);
    unsigned char* ws = a.ws;
    const bf16_t* bgp = (const bf16_t*)(ws + WS_BG); const bf16_t* up = (const bf16_t*)(ws + WS_U); const bf16_t* qp = (const bf16_t*)(ws + WS_Q);
    const bf16_t* kp = (const bf16_t*)(ws + WS_K); const bf16_t* vp = (const bf16_t*)(ws + WS_V); bf16_t* mm = (bf16_t*)(ws + WS_M);
    PG8_LAS float* ssq = (PG8_LAS float*)(lds + L_SSQ); PG8_LAS float* sQ = (PG8_LAS float*)(lds + L_SQ); PG8_LAS float* sP = (PG8_LAS float*)(lds + L_SP) + wid * 256;
    const int row = ROW_S + s;
    __syncthreads();
    if (tid < 128) { f32x4 x0, x1; unpack8(*(const u32x4*)(qp + (size_t)row * ATTD + tid * 8), x0, x1); *(PG8_LAS f32x4*)(sQ + tid * 8) = x0; *(PG8_LAS f32x4*)(sQ + tid * 8 + 4) = x1; }
    __syncthreads();
    const int kvh = wid >> 1, h0 = wid * 2;
    float sc[2][2];
    {
        const float* ck = a.in[I_CK] + (size_t)s * 128 * KVD + kvh * 64;
#pragma unroll
        for (int ks = 0; ks < 2; ++ks) { const float* kr = ck + (size_t)(lane + 64 * ks) * KVD; float a0 = 0.f, a1 = 0.f;
#pragma unroll
            for (int d4 = 0; d4 < 16; ++d4) { const f32x4 kv = *(const f32x4*)(kr + d4 * 4); const f32x4 q0 = *(const PG8_LAS f32x4*)(sQ + h0 * 64 + d4 * 4), q1 = *(const PG8_LAS f32x4*)(sQ + (h0 + 1) * 64 + d4 * 4);
                a0 += (kv[0] * q0[0] + kv[1] * q0[1]) + (kv[2] * q0[2] + kv[3] * q0[3]); a1 += (kv[0] * q1[0] + kv[1] * q1[1]) + (kv[2] * q1[2] + kv[3] * q1[3]); }
            sc[ks][0] = a0; sc[ks][1] = a1; }
    }
    const float knew = bf2f(kp[(size_t)row * KVD + kvh * 64 + lane]), vnew = bf2f(vp[(size_t)row * KVD + kvh * 64 + lane]);
    float pnew[2];
#pragma unroll
    for (int hh = 0; hh < 2; ++hh) {
        const float snew = wave_sum(knew * sQ[(h0 + hh) * 64 + lane]); const float sink = a.in[I_SINK][h0 + hh];
        float mx = wave_max(fmaxf(sc[0][hh], sc[1][hh])); mx = fmaxf(mx, fmaxf(snew, sink));
        const float p0 = __expf(sc[0][hh] - mx), p1 = __expf(sc[1][hh] - mx), pn = __expf(snew - mx);
        const float inv = 1.0f / (wave_sum(p0 + p1) + pn + __expf(sink - mx));
        sP[hh * 128 + lane] = p0 * inv; sP[hh * 128 + 64 + lane] = p1 * inv; pnew[hh] = pn * inv;
    }
    __syncthreads();
    float o0 = 0.f, o1 = 0.f;
    {
        const float* cv = a.in[I_CV] + (size_t)s * 128 * KVD + kvh * 64 + lane;
#pragma unroll 32
        for (int j = 0; j < 128; ++j) { const float vv = cv[(size_t)j * KVD]; o0 += sP[j] * vv; o1 += sP[128 + j] * vv; }
    }
    o0 += pnew[0] * vnew; o1 += pnew[1] * vnew;
    const float ss0 = wave_sum(o0 * o0), ss1 = wave_sum(o1 * o1);
    if (lane == 0) { ssq[h0] = ss0; ssq[h0 + 1] = ss1; }
    __syncthreads();
    {
        float tot = 0.f;
#pragma unroll
        for (int h = 0; h < 16; ++h) tot += ssq[h];
        const float rstd = rsqrtf(tot * (1.0f / ATTD) + EPS); const float* ag = a.in[I_AG];
        mm[(size_t)row * D + CONVD + h0 * 64 + lane] = (bf16_t)(cvt_pk_bf16(o0 * rstd * ag[h0 * 64 + lane], 0.f) & 0xffffu);
        mm[(size_t)row * D + CONVD + (h0 + 1) * 64 + lane] = (bf16_t)(cvt_pk_bf16(o1 * rstd * ag[(h0 + 1) * 64 + lane], 0.f) & 0xffffu);
        if ((wid & 1) == 0) { a.out[OFF_KS + (size_t)(s * 128 + 127) * KVD + kvh * 64 + lane] = knew; a.out[OFF_VS + (size_t)(s * 128 + 127) * KVD + kvh * 64 + lane] = vnew; }
    }
    if (wid == 0) {
        const float* cw = a.in[I_CW]; const float* cg = a.in[I_CG]; const float* st = a.in[I_ST] + (size_t)s * 2 * CONVD;
        f32x4 x[4]; float ss = 0.f;
#pragma unroll
        for (int i = 0; i < 2; ++i) { const int c = i * 512 + lane * 8;
            f32x4 u0a, u0b, ba, bb; unpack8(*(const u32x4*)(up + (size_t)row * CONVD + c), u0a, u0b); unpack8(*(const u32x4*)(bgp + (size_t)row * CONVD + c), ba, bb);
            const f32x4 u1a = *(const f32x4*)(st + CONVD + c), u1b = *(const f32x4*)(st + CONVD + c + 4), u2a = *(const f32x4*)(st + c), u2b = *(const f32x4*)(st + c + 4);
            x[i * 2] = ba * (*(const f32x4*)(cw + c) * u2a + *(const f32x4*)(cw + CONVD + c) * u1a + *(const f32x4*)(cw + 2 * CONVD + c) * u0a);
            x[i * 2 + 1] = bb * (*(const f32x4*)(cw + c + 4) * u2b + *(const f32x4*)(cw + CONVD + c + 4) * u1b + *(const f32x4*)(cw + 2 * CONVD + c + 4) * u0b);
            float* o = a.out + OFF_CS + (size_t)(s * 2 + 1) * CONVD + c; *(f32x4*)o = u0a; *(f32x4*)(o + 4) = u0b; }
#pragma unroll
        for (int e = 0; e < 4; ++e) ss += (x[e][0] * x[e][0] + x[e][1] * x[e][1]) + (x[e][2] * x[e][2] + x[e][3] * x[e][3]);
        ss = wave_sum(ss); const float rstd = rsqrtf(ss * (1.0f / CONVD) + EPS);
#pragma unroll
        for (int i = 0; i < 2; ++i) { const int c = i * 512 + lane * 8;
            *(u32x4*)(mm + (size_t)row * D + c) = pack8(x[i * 2] * rstd * *(const f32x4*)(cg + c), x[i * 2 + 1] * rstd * *(const f32x4*)(cg + c + 4)); }
    }
}

__device__ __forceinline__ void p6_final(const Args& a) {
    const int tid = threadIdx.x, lane = tid & 63, wid = tid >> 6;
    const float* ssp = (const float*)(a.ws + WS_SS2); const float* ssS = (const float*)(a.ws + WS_SSS2); const float* gf = a.in[I_GF]; const bf16_t* hp2 = (const bf16_t*)(a.ws + WS_HP2);
    for (int row0 = (blockIdx.x * 8 + wid) * 4; row0 < NREAL; row0 += gridDim.x * 32) {
        u32x4 h[4][4]; float t[4];
#pragma unroll
        for (int r = 0; r < 4; ++r) { const int row = row0 + r;
            t[r] = row < MP ? (lane < 32 ? ssp[(size_t)row * 32 + lane] : 0.f) : ssS[(row - MP) * 128 + lane] + ssS[(row - MP) * 128 + 64 + lane];
#pragma unroll
            for (int i = 0; i < 4; ++i) h[r][i] = *(const u32x4*)(hp2 + (size_t)row * D + (i * 64 + lane) * 8); }
#pragma unroll
        for (int r = 0; r < 4; ++r) { const float rstd = rsqrtf(wave_sum(t[r]) * (1.0f / D) + EPS); float* yr = a.out + (size_t)(row0 + r) * D;
#pragma unroll
            for (int i = 0; i < 4; ++i) { const int c = (i * 64 + lane) * 8; f32x4 x0, x1; unpack8(h[r][i], x0, x1);
                *(f32x4*)(yr + c) = x0 * rstd * *(const f32x4*)(gf + c); *(f32x4*)(yr + c + 4) = x1 * rstd * *(const f32x4*)(gf + c + 4); } }
    }
}

constexpr int LDS_BYTES = pg8::STAGE_BYTES;
__global__ void __launch_bounds__(NTHREADS, 2) hymba_fwd(Args a) {
    extern __shared__ __attribute__((aligned(16))) unsigned char lds_raw[];
    PG8_LAS unsigned char* lds = (PG8_LAS unsigned char*)lds_raw;
    cg::grid_group grid = cg::this_grid();
    unsigned char* ws = a.ws;
#ifndef PROBE_REP
#define PROBE_REP -1
#endif
#define NREP(k) ((k) == PROBE_REP ? 2 : 1)
#define IN(k) (a.ph_lo <= (k) && (k) < a.ph_hi)
#define SEAM(k) do { if (IN(k) && IN((k) + 1)) grid.sync(); } while (0)
    if (IN(0)) for (int rep = 0; rep < NREP(0); ++rep) { if (rep) grid.sync(); p0_prep(a, lds); }
    SEAM(0);
    if (IN(1)) for (int rep = 0; rep < NREP(1); ++rep) { if (rep) grid.sync();
        pg8::Gemm g{(const bf16_t*)(ws + WS_HN), (const bf16_t*)(ws + WS_WIN), MROWS, INC, D}; pg8::StaticOrder S; S.init(MROWS, INC, (int)gridDim.x, (int)blockIdx.x);
        EpiIn E{(bf16_t*)(ws + WS_BG), (bf16_t*)(ws + WS_U), (bf16_t*)(ws + WS_Q), (bf16_t*)(ws + WS_K), (bf16_t*)(ws + WS_V), (const float*)(ws + WS_ROPE)};
        pg8::gemm_phase<EpiIn, pg8::StaticOrder>(lds, g, S, E);
        p1_slack_convert(a, lds);
    }
    SEAM(1);
    if (IN(2)) for (int rep = 0; rep < NREP(2); ++rep) { if (rep) grid.sync();
        for (int item = blockIdx.x; item < 256 + NS; item += gridDim.x) { if (item < 256) p2_prompt_item(a, lds, item); else p2_sample_item(a, lds, item - 256); }
    }
    SEAM(2);
    if (IN(3)) for (int rep = 0; rep < NREP(3); ++rep) { if (rep) grid.sync();
        { SkOut E{a.in[I_XS], (bf16_t*)(ws + WS_HN), (float*)(ws + WS_SSS1)};
          skinny_gemm<1, SkOut>((const bf16_t*)(ws + WS_M) + (size_t)ROW_S * D, (const bf16_t*)(ws + WS_WOUT), D, D / 16, E, lds); }
        pg8::Gemm g{(const bf16_t*)(ws + WS_M), (const bf16_t*)(ws + WS_WOUT), MP, D, D}; pg8::StaticOrder S; S.init(MP, D, (int)gridDim.x, (int)blockIdx.x);
        EpiOut E{a.in[I_XP], (bf16_t*)(ws + WS_HN), (float*)(ws + WS_SS1)};
        pg8::gemm_phase<EpiOut, pg8::StaticOrder>(lds, g, S, E);
    }
    SEAM(3);
    if (IN(4)) for (int rep = 0; rep < NREP(4); ++rep) { if (rep) grid.sync();
        { const int lane = threadIdx.x & 63, r = (threadIdx.x >> 6) * 16 + (lane & 15), fq = lane >> 4; const float* sp = (const float*)(ws + WS_SSS1) + r * 128 + fq * 32; float t = 0.f;
#pragma unroll
          for (int i = 0; i < 8; ++i) { const f32x4 v = *(const f32x4*)(sp + 4 * i); t += (v[0] + v[1]) + (v[2] + v[3]); }
          t += __shfl_xor(t, 16); t += __shfl_xor(t, 32);
          SkGU E{(bf16_t*)(ws + WS_HF), rsqrtf(t * (1.0f / D) + EPS)};
          skinny_gemm<2, SkGU>((const bf16_t*)(ws + WS_HN) + (size_t)ROW_S * D, (const bf16_t*)(ws + WS_WGU), D, FF / 16, E, lds); }
        pg8::Gemm g{(const bf16_t*)(ws + WS_HN), (const bf16_t*)(ws + WS_WGU), MP, GU, D}; pg8::StaticOrder S; S.init(MP, GU, (int)gridDim.x, (int)blockIdx.x);
        EpiGU E{(const float*)(ws + WS_SS1), (bf16_t*)(ws + WS_HF)};
        pg8::gemm_phase<EpiGU, pg8::StaticOrder>(lds, g, S, E);
    }
    SEAM(4);
    if (IN(5)) for (int rep = 0; rep < NREP(5); ++rep) { if (rep) grid.sync();
        { SkDown E{(const bf16_t*)(ws + WS_HN), (bf16_t*)(ws + WS_HP2), (float*)(ws + WS_SSS2)};
          skinny_gemm<1, SkDown>((const bf16_t*)(ws + WS_HF) + (size_t)ROW_S * FF, (const bf16_t*)(ws + WS_WDN), FF, D / 16, E, lds); }
        pg8::Gemm g{(const bf16_t*)(ws + WS_HF), (const bf16_t*)(ws + WS_WDN), MP, D, FF}; pg8::StaticOrder S; S.init(MP, D, (int)gridDim.x, (int)blockIdx.x);
        EpiDown E{(const bf16_t*)(ws + WS_HN), (bf16_t*)(ws + WS_HP2), (float*)(ws + WS_SS2)};
        pg8::gemm_phase<EpiDown, pg8::StaticOrder>(lds, g, S, E);
    }
    SEAM(5);
    if (IN(6)) p6_final(a);
#if defined(PROBE_NULL)
    if (IN(7)) {
        pg8::Gemm g{(const bf16_t*)(ws + WS_HN), (const bf16_t*)(ws + WS_WGU), MP, GU, D}; pg8::StaticOrder S; S.init(MP, GU, (int)gridDim.x, (int)blockIdx.x);
        EpiNull E{};
        pg8::gemm_phase<EpiNull, pg8::StaticOrder>(lds, g, S, E);
    }
#endif
#undef IN
#undef SEAM
}

#ifndef ONE_LAUNCH
#define ONE_LAUNCH 1
#endif
#ifndef HOST_REP
#define HOST_REP -1
#endif
extern "C" void kernel_launch(void* const* d_in, const int* in_sizes, int n_in, void* d_out, int out_size, void* d_ws, size_t ws_size, hipStream_t stream) {
    static int grid = 0;
    if (grid == 0) {
        if (n_in != 18 || (size_t)out_size != OUT_TOTAL || ws_size < WS_END) { fprintf(stderr, "kernel_launch: unexpected shapes: n_in %d out %d ws %zu (need %zu)\n", n_in, out_size, ws_size, (size_t)WS_END); grid = -1; return; }
        int dev = 0, cus = 0, per_cu = 0;
        (void)hipGetDevice(&dev); (void)hipDeviceGetAttribute(&cus, hipDeviceAttributeMultiprocessorCount, dev);
        if (hipFuncSetAttribute((const void*)hymba_fwd, hipFuncAttributeMaxDynamicSharedMemorySize, LDS_BYTES) != hipSuccess) { fprintf(stderr, "kernel_launch: hipFuncSetAttribute failed\n"); grid = -1; return; }
        if (hipOccupancyMaxActiveBlocksPerMultiprocessor(&per_cu, (const void*)hymba_fwd, NTHREADS, LDS_BYTES) != hipSuccess || per_cu < 1) { fprintf(stderr, "kernel_launch: occupancy query says %d blocks per CU\n", per_cu); grid = -1; return; }
        grid = cus;
    }
    if (grid < 0) return;
    Args a{};
    for (int i = 0; i < 18; ++i) a.in[i] = (const float*)d_in[i];
    a.out = (float*)d_out; a.ws = (unsigned char*)d_ws;
#if ONE_LAUNCH
    a.ph_lo = 0; a.ph_hi = 7;
    void* args[] = {&a};
    hipError_t e = hipLaunchCooperativeKernel((const void*)hymba_fwd, dim3(grid), dim3(NTHREADS), args, LDS_BYTES, stream);
    if (e != hipSuccess) fprintf(stderr, "cooperative launch failed: %s (grid %d)\n", hipGetErrorString(e), grid);
#else
    for (int ph = 0; ph < (HOST_REP == 7 ? 8 : 7); ++ph) for (int rep = 0; rep < (ph == HOST_REP ? 2 : 1); ++rep) { a.ph_lo = ph; a.ph_hi = ph + 1; hipLaunchKernelGGL(hymba_fwd, dim3(grid), dim3(NTHREADS), LDS_BYTES, stream, a); }
#endif
}
```
